# Optimizing an MI355X kernel written in HIP

```python
import jax, jax.numpy as jnp
from jax import lax
import numpy as np

D_MODEL = 2048
BATCH = 1
SEQ = 8192
DEPTH = 1

CHUNK = 64
D_PLE = 256

FOX_HEAD_DIM = 64
FOX_WIDTH = D_MODEL // 2
FOX_HEADS = FOX_WIDTH // FOX_HEAD_DIM
Q_BLOCK = 128

SSD_HEAD_DIM = 64
SSD_WIDTH = D_MODEL // 2
SSD_HEADS = SSD_WIDTH // SSD_HEAD_DIM
SSD_GROUPS = 2
SSD_STATE = 128
SSD_CONV = 4
SSD_CONV_DIM = SSD_WIDTH + 2 * SSD_GROUPS * SSD_STATE

MIX_WIDTH = FOX_WIDTH + SSD_WIDTH

IN_SPLITS = [
    FOX_WIDTH,
    FOX_WIDTH,
    FOX_WIDTH,
    FOX_HEADS,
    SSD_WIDTH,
    SSD_GROUPS * SSD_STATE,
    SSD_GROUPS * SSD_STATE,
    SSD_WIDTH,
    SSD_HEADS,
]
IN_COLS = int(sum(IN_SPLITS))

D_FF = 5632
FFN_CONV = 3

EPS = 1e-6

kernel_name = "hybrid_fox_ssd_convffn_ple"


def rmsnorm(u, w):
    uf = u.astype(jnp.float32)
    y = uf * lax.rsqrt(jnp.mean(uf * uf, axis=-1, keepdims=True) + EPS)
    return (y * w.astype(jnp.float32)).astype(u.dtype)


def causal_dwconv(u, w, b):
    K = w.shape[0]
    S = u.shape[1]
    up = jnp.pad(u, ((0, 0), (K - 1, 0), (0, 0)))
    return sum(up[:, k:k + S] * w[k] for k in range(K)) + b


def fox_attention(q, k, v, f_logit, b_f):
    Bsz, S, _ = q.shape
    H, Dh = FOX_HEADS, FOX_HEAD_DIM
    scale = Dh ** -0.5
    qh = q.reshape(Bsz, S, H, Dh).transpose(0, 2, 1, 3).astype(jnp.float32)
    kh = k.reshape(Bsz, S, H, Dh).transpose(0, 2, 1, 3).astype(jnp.float32)
    vh = v.reshape(Bsz, S, H, Dh).transpose(0, 2, 1, 3).astype(jnp.float32)
    log_f = jax.nn.log_sigmoid(f_logit.astype(jnp.float32) + b_f.astype(jnp.float32))
    c = jnp.cumsum(log_f, axis=1).transpose(0, 2, 1)
    n_blk = S // Q_BLOCK
    q_blk = qh.reshape(Bsz, H, n_blk, Q_BLOCK, Dh).transpose(2, 0, 1, 3, 4)
    c_blk = c.reshape(Bsz, H, n_blk, Q_BLOCK).transpose(2, 0, 1, 3)
    k_pos = jnp.arange(S)

    def one_block(args):
        qb, cb, i = args
        s = jnp.einsum('bhqd,bhkd->bhqk', qb, kh) * scale
        s = s + cb[..., :, None] - c[..., None, :]
        q_pos = i * Q_BLOCK + jnp.arange(Q_BLOCK)
        mask = k_pos[None, :] <= q_pos[:, None]
        s = jnp.where(mask[None, None], s, -jnp.inf)
        pr = jax.nn.softmax(s, axis=-1)
        return jnp.einsum('bhqk,bhkd->bhqd', pr, vh)

    out = lax.map(one_block, (q_blk, c_blk, jnp.arange(n_blk)))
    out = out.transpose(1, 0, 3, 2, 4).reshape(Bsz, S, H * Dh)
    return out.astype(q.dtype)


def ssd_mixer(xs, Bm, Cm, z, dt_raw, conv_w, conv_b, dt_bias, A_log, D_skip, norm_w):
    Bsz, S, _ = xs.shape
    H, P, G, N, L = SSD_HEADS, SSD_HEAD_DIM, SSD_GROUPS, SSD_STATE, CHUNK
    nc = S // L
    xbc = jnp.concatenate([xs, Bm, Cm], axis=-1)
    xbc = jax.nn.silu(causal_dwconv(xbc, conv_w, conv_b))
    xs, Bm, Cm = jnp.split(xbc, [SSD_WIDTH, SSD_WIDTH + G * N], axis=-1)

    xc = xs.astype(jnp.float32).reshape(Bsz, nc, L, H, P)
    Bc = Bm.astype(jnp.float32).reshape(Bsz, nc, L, G, N)
    Cc = Cm.astype(jnp.float32).reshape(Bsz, nc, L, G, N)
    dt = jax.nn.softplus(dt_raw.astype(jnp.float32) + dt_bias.astype(jnp.float32))
    A = -jnp.exp(A_log.astype(jnp.float32))
    dtc = dt.reshape(Bsz, nc, L, H)
    a_cum = jnp.cumsum(dtc * A, axis=2)

    rep = H // G
    Bh = jnp.repeat(Bc, rep, axis=3)
    Ch = jnp.repeat(Cc, rep, axis=3)

    causal = jnp.tril(jnp.ones((L, L), dtype=bool))
    seg = a_cum[:, :, :, None, :] - a_cum[:, :, None, :, :]
    decay = jnp.exp(jnp.where(causal[None, None, :, :, None], seg, -jnp.inf))
    CB = jnp.einsum('bclgn,bcsgn->bcgls', Cc, Bc)
    CB = jnp.repeat(CB, rep, axis=2)
    y_diag = jnp.einsum('bchls,bclsh,bcsh,bcshp->bclhp', CB, decay, dtc, xc)

    decay_to_end = jnp.exp(a_cum[:, :, -1:, :] - a_cum)
    states = jnp.einsum('bcshn,bcsh,bcsh,bcshp->bchpn', Bh, decay_to_end, dtc, xc)
    chunk_decay = jnp.exp(a_cum[:, :, -1, :])

    def step(h, inp):
        st, dec = inp
        return h * dec[..., None, None] + st, h

    h0 = jnp.zeros((Bsz, H, P, N), jnp.float32)
    _, h_prev = lax.scan(step, h0, (states.transpose(1, 0, 2, 3, 4), chunk_decay.transpose(1, 0, 2)))
    h_prev = h_prev.transpose(1, 0, 2, 3, 4)
    y_off = jnp.einsum('bclhn,bchpn,bclh->bclhp', Ch, h_prev, jnp.exp(a_cum))

    y = y_diag + y_off + D_skip.astype(jnp.float32)[:, None] * xc
    y = y.reshape(Bsz, S, H * P)
    y = y * jax.nn.silu(z.astype(jnp.float32))
    return rmsnorm(y, norm_w).astype(xs.dtype)


def setup_inputs(seed: int = 0) -> dict:
    key = jax.random.key(seed)
    ks = jax.random.split(key, 24)
    f32 = jnp.float32

    def nrm(k, shape, scale):
        return jax.random.normal(k, shape, f32) * scale

    def gain(k, shape):
        return 1.0 + 0.05 * jax.random.normal(k, shape, f32)

    dt0 = jnp.exp(jax.random.uniform(ks[8], (DEPTH, SSD_HEADS), f32,
                                     np.log(1e-3).astype(np.float32), np.log(1e-1).astype(np.float32)))
    dt_bias = dt0 + jnp.log(-jnp.expm1(-dt0))
    return {
        "x": jax.random.normal(ks[0], (BATCH, SEQ, D_MODEL), f32),
        "p": jax.random.normal(ks[1], (DEPTH, BATCH, SEQ, D_PLE), f32),
        "mix_norm_w": gain(ks[2], (DEPTH, D_MODEL)),
        "w_in": nrm(ks[3], (DEPTH, D_MODEL, IN_COLS), D_MODEL ** -0.5),
        "fox_forget_bias": jax.random.uniform(ks[4], (DEPTH, FOX_HEADS), f32, 1.0, 4.0),
        "ssd_conv_w": nrm(ks[5], (DEPTH, SSD_CONV, SSD_CONV_DIM), SSD_CONV ** -0.5),
        "ssd_conv_b": nrm(ks[6], (DEPTH, SSD_CONV_DIM), 0.02),
        "ssd_dt_bias": dt_bias,
        "ssd_A_log": jnp.log(jax.random.uniform(ks[7], (DEPTH, SSD_HEADS), f32, 1.0, 16.0)),
        "ssd_D": gain(ks[9], (DEPTH, SSD_HEADS)),
        "ssd_norm_w": gain(ks[10], (DEPTH, SSD_WIDTH)),
        "w_out": nrm(ks[11], (DEPTH, MIX_WIDTH, D_MODEL), MIX_WIDTH ** -0.5),
        "ffn_norm_w": gain(ks[12], (DEPTH, D_MODEL)),
        "w_gate_up": nrm(ks[13], (DEPTH, D_MODEL, 2 * D_FF), D_MODEL ** -0.5),
        "ffn_conv_w": nrm(ks[14], (DEPTH, FFN_CONV, D_FF), FFN_CONV ** -0.5),
        "ffn_conv_b": nrm(ks[15], (DEPTH, D_FF), 0.02),
        "w_down": nrm(ks[16], (DEPTH, D_FF, D_MODEL), D_FF ** -0.5),
        "ple_norm_w": gain(ks[17], (DEPTH, D_MODEL)),
        "w_ple_gate": nrm(ks[18], (DEPTH, D_MODEL, D_MODEL), D_MODEL ** -0.5),
        "w_ple_proj": nrm(ks[19], (DEPTH, D_PLE, D_MODEL), D_PLE ** -0.5),
        "final_norm_w": gain(ks[20], (D_MODEL,)),
    }


def reference(x, p, mix_norm_w, w_in, fox_forget_bias, ssd_conv_w, ssd_conv_b, ssd_dt_bias,
              ssd_A_log, ssd_D, ssd_norm_w, w_out, ffn_norm_w, w_gate_up, ffn_conv_w,
              ffn_conv_b, w_down, ple_norm_w, w_ple_gate, w_ple_proj, final_norm_w):
    split_idx = [int(v) for v in np.cumsum(IN_SPLITS)[:-1]]
    for i in range(DEPTH):
        h = rmsnorm(x, mix_norm_w[i])
        u = h @ w_in[i]
        q, k, v, f_logit, xs, Bm, Cm, z, dt_raw = jnp.split(u, split_idx, axis=-1)
        y_fox = fox_attention(q, k, v, f_logit, fox_forget_bias[i])
        y_ssd = ssd_mixer(xs, Bm, Cm, z, dt_raw, ssd_conv_w[i], ssd_conv_b[i], ssd_dt_bias[i],
                          ssd_A_log[i], ssd_D[i], ssd_norm_w[i])
        x = x + jnp.concatenate([y_fox, y_ssd], axis=-1) @ w_out[i]

        h = rmsnorm(x, ffn_norm_w[i])
        g, up = jnp.split(h @ w_gate_up[i], [D_FF], axis=-1)
        g = causal_dwconv(g, ffn_conv_w[i], ffn_conv_b[i])
        x = x + (jax.nn.silu(g) * up) @ w_down[i]

        h = rmsnorm(x, ple_norm_w[i])
        gate = jax.nn.sigmoid(h @ w_ple_gate[i])
        x = x + gate * (p[i] @ w_ple_proj[i])
    return rmsnorm(x, final_norm_w)
```

```cpp
#include <hip/hip_runtime.h>
#include <hip/hip_cooperative_groups.h>
#include <cstdio>
#include <cstdint>
namespace cg = cooperative_groups;
namespace pg8 {
#define PG8_LAS __attribute__((address_space(3)))
typedef unsigned short bf16_t;
typedef short bf16x8 __attribute__((ext_vector_type(8)));
typedef float f32x4 __attribute__((ext_vector_type(4)));
typedef unsigned u32x4 __attribute__((ext_vector_type(4)));
constexpr int BM = 256, BK = 64, HALF = 128, HTB = HALF * BK * 2  , STAGE_BYTES = 8 * HTB, NXCD = 8, WGM = 8;

__host__ __device__ __forceinline__ int lds_byte(int r, int c) { const int st = (r >> 4) * 2 + (c >> 5), rr = r & 15, cc = c & 31, ob = rr * 64 + cc * 2; return st * 1024 + (ob ^ (((ob >> 9) & 1) << 5)); }
__host__ __device__ __forceinline__ void stage_rc(int b, int& R, int& C) { const int st = b / 1024, sb = b % 1024, swz = sb ^ (((sb >> 9) & 1) << 5); R = (st >> 1) * 16 + swz / 64; C = (st & 1) * 32 + (swz % 64) / 2; }
__host__ __device__ __forceinline__ int perm32(int rho) { const int n = rho >> 4, i = rho & 15; return 8 * (i >> 2) + 4 * n + (i & 3); }

struct Unit { int pm, pn; };
struct Gemm { const bf16_t* A; const bf16_t* Bt; int M, N, K, lda; };

struct StaticOrder {
    int nM, nN, nwg, G, c;
    __host__ __device__ void init(int M, int N, int G_, int c_) { nM = M / BM; nN = N / BM; nwg = nM * nN; G = G_; c = c_; }
    __host__ __device__ bool next(int i, Unit& u) const {
        const long L = (long)i * G + c; if (L >= nwg) return false;
        int wgid = (int)L; { const int q = nwg / NXCD, r = nwg % NXCD, xcd = wgid % NXCD, off = wgid / NXCD; wgid = (xcd < r ? xcd * (q + 1) : r * (q + 1) + (xcd - r) * q) + off; }
        const int nig = WGM * nN, gid = wgid / nig, fm = gid * WGM, gsz = (nM - fm) < WGM ? (nM - fm) : WGM;
        u.pm = fm + ((wgid % nig) % gsz); u.pn = (wgid % nig) / gsz; return true;
    }
    __device__ __forceinline__ void a_ready(const Unit&) const {}
    __device__ __forceinline__ void done(const Unit&) const {}
};

__device__ __forceinline__ unsigned cvt_pk_bf16(float lo, float hi) { unsigned r; asm volatile("v_cvt_pk_bf16_f32 %0, %1, %2" : "=v"(r) : "v"(lo), "v"(hi)); return r; }
typedef float f32x2 __attribute__((ext_vector_type(2)));
__device__ __forceinline__ f32x2 gelu_pk(f32x2 v) {
    const f32x2 av = __builtin_elementwise_abs(v), d = av * 0.2316418882f + 1.0f;
    f32x2 t; t.x = __builtin_amdgcn_rcpf(d.x); t.y = __builtin_amdgcn_rcpf(d.y);
    f32x2 q = t * 0.5307027145f + (-0.7265760135f); q = q * t + 0.7107068705f; q = q * t + (-0.142248368f); q = q * t + 0.127414796f; q = q * t;
    const f32x2 s = (v * v) * (-0.72134752044f);
    f32x2 e; e.x = __builtin_amdgcn_exp2f(s.x); e.y = __builtin_amdgcn_exp2f(s.y);
    const f32x2 m = v * (q * e), r = v - m;
    f32x2 o; o.x = v.x < 0.f ? m.x : r.x; o.y = v.y < 0.f ? m.y : r.y; return o;
}

template <int ACT  > struct EpiBf16 {
    static constexpr bool PERM = true, AFTER_DRAIN = false; static_assert(ACT == 0 || ACT == 1, "EpiBf16: ACT is 0 (none) or 1 (gelu_pk)");
    bf16_t* O; int ldc; const float* bias; int split_cols; size_t split_stride; float scale0;
    __device__ __forceinline__ void operator()(const f32x4 (&acc)[2][2][4][2], const Unit& u, int wr, int wc, int fr, int fq) const {
        const int row0 = u.pm * BM + wr * 64 + fr; int colt = u.pn * BM; bf16_t* base = O;
        float sc = 1.f; if (split_cols) { const int t = colt / split_cols; base += (size_t)t * split_stride; colt -= t * split_cols; if (t == 0) sc = scale0; }
        const int col0 = colt + wc * 32 + 8 * fq, bcol0 = u.pn * BM + wc * 32 + 8 * fq;
        f32x4 bv[2][2];
#pragma unroll
        for (int bj = 0; bj < 2; ++bj)
#pragma unroll
            for (int n = 0; n < 2; ++n) bv[bj][n] = bias ? *(const f32x4*)(bias + bcol0 + bj * HALF + 4 * n) : (f32x4){0.f, 0.f, 0.f, 0.f};
#pragma unroll
        for (int ai = 0; ai < 2; ++ai)
#pragma unroll
            for (int m = 0; m < 4; ++m) { bf16_t* rowp = base + (size_t)(row0 + ai * HALF + m * 16) * ldc + col0;
#pragma unroll
                for (int bj = 0; bj < 2; ++bj) { f32x4 v0 = acc[ai][bj][m][0] + bv[bj][0], v1 = acc[ai][bj][m][1] + bv[bj][1];
                    if (ACT == 1) { f32x2 a = gelu_pk((f32x2){v0[0], v0[1]}), b = gelu_pk((f32x2){v0[2], v0[3]}), c = gelu_pk((f32x2){v1[0], v1[1]}), d = gelu_pk((f32x2){v1[2], v1[3]});
                        v0 = (f32x4){a.x, a.y, b.x, b.y}; v1 = (f32x4){c.x, c.y, d.x, d.y}; }
                    v0 = v0 * sc; v1 = v1 * sc; u32x4 w; w.x = cvt_pk_bf16(v0[0], v0[1]); w.y = cvt_pk_bf16(v0[2], v0[3]); w.z = cvt_pk_bf16(v1[0], v1[1]); w.w = cvt_pk_bf16(v1[2], v1[3]);
                    *(u32x4*)(rowp + bj * HALF) = w; } }
    }
};
template <class Epi, class Sched, bool ALIGN_EPI = false, bool SP2 = false>
__device__ __forceinline__ void gemm_phase(PG8_LAS unsigned char* lds, const Gemm g, const Sched& S, const Epi& E) {
    const int tid = threadIdx.x, wid = __builtin_amdgcn_readfirstlane(tid >> 6), lane = tid & 63, wr = wid >> 2, wc = wid & 3, fr = lane & 15, fq = lane >> 4;
    const int K = g.K, nt = K / BK;
    unsigned voffA[2], voffB[2];
#pragma unroll
    for (int i = 0; i < 2; ++i) { int R, C; stage_rc(tid * 16 + i * 8192, R, C); const int Rb = Epi::PERM ? ((R & ~31) + perm32(R & 31)) : R;
        voffA[i] = (unsigned)(R * g.lda + C) * 2u; voffB[i] = (unsigned)(Rb * K + C) * 2u; }
    const size_t kstep = (size_t)(BK * 2);
    const size_t hstepA = (size_t)HALF * g.lda * 2, hstepB = (size_t)HALF * K * 2;
    const size_t tstepA = 2 * hstepA, tstepB = 2 * hstepB;
    const unsigned ldsw = (unsigned)wid * 1024u;
    const int aoff = lds_byte(wr * 64 + fr, fq * 8), boff = lds_byte(wc * 32 + fr, fq * 8);
#define PG8_SA(b, h) (((b) * 2 + (h)) * HTB)
#define PG8_SB(b, h) ((4 + (b) * 2 + (h)) * HTB)
#define PG8_STAGE(bufoff, gbase, voff) do { _Pragma("unroll") for (int _i = 0; _i < 2; ++_i) \
        __builtin_amdgcn_global_load_lds((const unsigned*)((const char*)(gbase) + (voff)[_i]), (PG8_LAS unsigned*)(lds + (bufoff) + ldsw + _i * 8192), 16, 0, 0); } while (0)
#define PG8_LDA(dst, b, h) do { _Pragma("unroll") for (int m = 0; m < 4; ++m) _Pragma("unroll") for (int k = 0; k < 2; ++k) dst[m][k] = *(const PG8_LAS bf16x8*)(lds + PG8_SA(b, h) + aoff + m * 2048 + k * 1024); } while (0)
#define PG8_LDB(dst, b, h) do { _Pragma("unroll") for (int n = 0; n < 2; ++n) _Pragma("unroll") for (int k = 0; k < 2; ++k) dst[n][k] = *(const PG8_LAS bf16x8*)(lds + PG8_SB(b, h) + boff + n * 2048 + k * 1024); } while (0)
#define PG8_MMA(ai, bj, At, Bt) do { __builtin_amdgcn_s_setprio(1); _Pragma("unroll") for (int m = 0; m < 4; ++m) _Pragma("unroll") for (int n = 0; n < 2; ++n) _Pragma("unroll") for (int k = 0; k < 2; ++k) \
        acc[ai][bj][m][n] = __builtin_amdgcn_mfma_f32_16x16x32_bf16(Bt[n][k], At[m][k], acc[ai][bj][m][n], 0, 0, 0); __builtin_amdgcn_s_setprio(0); } while (0)
#define PG8_WAIT_V(n) asm volatile("s_waitcnt vmcnt(" #n ")" ::: "memory")
#define PG8_WAIT_L(n) asm volatile("s_waitcnt lgkmcnt(" #n ")" ::: "memory")
#define PG8_BAR __builtin_amdgcn_s_barrier()
#define PG8_SCHED __builtin_amdgcn_sched_barrier(0)
    Unit cur, nxt; int ui = 0;
    if (!S.next(0, cur)) return;
    f32x4 acc[2][2][4][2];
#pragma unroll
    for (int a = 0; a < 2; ++a)
#pragma unroll
        for (int b = 0; b < 2; ++b)
#pragma unroll
            for (int m = 0; m < 4; ++m)
#pragma unroll
                for (int n = 0; n < 2; ++n) acc[a][b][m][n] = (f32x4){0.f, 0.f, 0.f, 0.f};
    bf16x8 At[4][2], B0[2][2], B1[2][2];
    const char* cA = (const char*)g.A + (size_t)cur.pm * tstepA; const char* cB = (const char*)g.Bt + (size_t)cur.pn * tstepB;
    S.a_ready(cur);
    if constexpr (SP2) {
        PG8_STAGE(PG8_SB(0, 0), cB, voffB); PG8_STAGE(PG8_SB(0, 1), cB + hstepB, voffB); PG8_STAGE(PG8_SA(0, 0), cA, voffA); PG8_STAGE(PG8_SA(0, 1), cA + hstepA, voffA);
        if (wr == 1) PG8_BAR;
        PG8_WAIT_V(2); PG8_BAR;
        PG8_STAGE(PG8_SB(1, 0), cB + kstep, voffB); PG8_STAGE(PG8_SA(1, 0), cA + kstep, voffA); PG8_STAGE(PG8_SB(1, 1), cB + hstepB + kstep, voffB);
        PG8_WAIT_V(6); PG8_BAR;
    } else {
        PG8_STAGE(PG8_SB(0, 0), cB, voffB); PG8_STAGE(PG8_SA(0, 0), cA, voffA); PG8_STAGE(PG8_SB(0, 1), cB + hstepB, voffB); PG8_STAGE(PG8_SA(0, 1), cA + hstepA, voffA);
        if (wr == 1) PG8_BAR;
        PG8_WAIT_V(4); PG8_BAR;
        PG8_STAGE(PG8_SB(1, 0), cB + kstep, voffB); PG8_STAGE(PG8_SA(1, 0), cA + kstep, voffA); PG8_STAGE(PG8_SB(1, 1), cB + hstepB + kstep, voffB);
        PG8_WAIT_V(6); PG8_BAR;
    }
    for (;;) {
        const bool has_next = S.next(ui + 1, nxt);
        const char* nA = has_next ? (const char*)g.A + (size_t)nxt.pm * tstepA : cA; const char* nB = has_next ? (const char*)g.Bt + (size_t)nxt.pn * tstepB : cB;
        for (int t = 0; t < nt; t += 2) {
            const bool last = (t == nt - 2);
            const char* a1 = cA + (size_t)(t + 1) * kstep;
            const char* a2 = last ? nA : cA + (size_t)(t + 2) * kstep; const char* b2 = last ? nB : cB + (size_t)(t + 2) * kstep;
            const char* a3 = a2 + kstep; const char* b3 = b2 + kstep;
            if (last && has_next) S.a_ready(nxt);
            if constexpr (SP2) {
            PG8_LDB(B0, 0, 0); PG8_LDB(B1, 0, 1); PG8_SCHED; PG8_LDA(At, 0, 0); PG8_STAGE(PG8_SA(1, 1), a1 + hstepA, voffA);
            PG8_WAIT_V(8); PG8_WAIT_L(0); PG8_BAR; PG8_MMA(0, 0, At, B0); PG8_MMA(0, 1, At, B1); PG8_BAR; PG8_SCHED;
            PG8_LDA(At, 0, 1); PG8_STAGE(PG8_SB(0, 0), b2, voffB); PG8_STAGE(PG8_SB(0, 1), b2 + hstepB, voffB); PG8_STAGE(PG8_SA(0, 0), a2, voffA);
            PG8_WAIT_V(8); PG8_WAIT_L(0); PG8_BAR; PG8_MMA(1, 0, At, B0); PG8_MMA(1, 1, At, B1); PG8_BAR; PG8_SCHED;
            PG8_LDB(B0, 1, 0); PG8_LDB(B1, 1, 1); PG8_SCHED; PG8_LDA(At, 1, 0); PG8_STAGE(PG8_SA(0, 1), a2 + hstepA, voffA);
            PG8_WAIT_V(8); PG8_WAIT_L(0); PG8_BAR; PG8_MMA(0, 0, At, B0); PG8_MMA(0, 1, At, B1); PG8_BAR; PG8_SCHED;
            PG8_LDA(At, 1, 1); PG8_STAGE(PG8_SB(1, 0), b3, voffB); PG8_STAGE(PG8_SB(1, 1), b3 + hstepB, voffB); PG8_STAGE(PG8_SA(1, 0), a3, voffA);
            PG8_WAIT_V(8); PG8_WAIT_L(0); PG8_BAR; PG8_MMA(1, 0, At, B0); PG8_MMA(1, 1, At, B1); PG8_BAR; PG8_SCHED;
            } else {
            PG8_LDB(B0, 0, 0); PG8_SCHED; PG8_LDA(At, 0, 0); PG8_STAGE(PG8_SA(1, 1), a1 + hstepA, voffA);
            PG8_WAIT_L(8); PG8_BAR; PG8_WAIT_L(0); PG8_MMA(0, 0, At, B0); PG8_BAR; PG8_SCHED;
            PG8_LDB(B1, 0, 1); PG8_STAGE(PG8_SB(0, 0), b2, voffB);
            PG8_BAR; PG8_WAIT_L(0); PG8_MMA(0, 1, At, B1); PG8_BAR;
            PG8_LDA(At, 0, 1); PG8_STAGE(PG8_SA(0, 0), a2, voffA);
            PG8_BAR; PG8_WAIT_L(0); PG8_MMA(1, 0, At, B0); PG8_BAR; PG8_SCHED;
            PG8_STAGE(PG8_SB(0, 1), b2 + hstepB, voffB);
            PG8_WAIT_V(6); PG8_BAR; PG8_MMA(1, 1, At, B1); PG8_BAR;
            PG8_LDB(B0, 1, 0); PG8_SCHED; PG8_LDA(At, 1, 0); PG8_STAGE(PG8_SA(0, 1), a2 + hstepA, voffA);
            PG8_WAIT_L(8); PG8_BAR; PG8_WAIT_L(0); PG8_MMA(0, 0, At, B0); PG8_BAR; PG8_SCHED;
            PG8_LDB(B1, 1, 1); PG8_STAGE(PG8_SB(1, 0), b3, voffB);
            PG8_BAR; PG8_WAIT_L(0); PG8_MMA(0, 1, At, B1); PG8_BAR;
            PG8_LDA(At, 1, 1); PG8_STAGE(PG8_SA(1, 0), a3, voffA);
            PG8_BAR; PG8_WAIT_L(0); PG8_MMA(1, 0, At, B0); PG8_BAR; PG8_SCHED;
            PG8_STAGE(PG8_SB(1, 1), b3 + hstepB, voffB);
            PG8_WAIT_V(6); PG8_BAR; PG8_MMA(1, 1, At, B1); PG8_BAR;
            }
        }
        if constexpr (ALIGN_EPI) { if (wr == 0) PG8_BAR; }
        if constexpr (!Epi::AFTER_DRAIN) { E(acc, cur, wr, wc, fr, fq); S.done(cur); }
        if (!has_next) break;
#pragma unroll
        for (int a = 0; a < 2; ++a)
#pragma unroll
            for (int b = 0; b < 2; ++b)
#pragma unroll
                for (int m = 0; m < 4; ++m)
#pragma unroll
                    for (int n = 0; n < 2; ++n) acc[a][b][m][n] = (f32x4){0.f, 0.f, 0.f, 0.f};
        cur = nxt; cA = nA; cB = nB; ++ui;
        if constexpr (ALIGN_EPI) { if (wr == 1) PG8_BAR; }
    }
    PG8_WAIT_V(0);
    if constexpr (!ALIGN_EPI) { if (wr == 0) PG8_BAR; }
    PG8_BAR;
    if constexpr (Epi::AFTER_DRAIN) { E.fused(acc, cur, wr, wc, fr, fq, lds, wid, lane); S.done(cur); }
#undef PG8_SA
#undef PG8_SB
#undef PG8_STAGE
#undef PG8_LDA
#undef PG8_LDB
#undef PG8_MMA
#undef PG8_WAIT_V
#undef PG8_WAIT_L
#undef PG8_BAR
#undef PG8_SCHED
}
}

namespace pg8 {
typedef unsigned u32x2v __attribute__((ext_vector_type(2)));
__device__ __forceinline__ unsigned pk_bf16(float lo, float hi) { typedef float f2 __attribute__((ext_vector_type(2))); typedef __bf16 b2 __attribute__((ext_vector_type(2))); f2 v = {lo, hi}; b2 b = __builtin_convertvector(v, b2); return __builtin_bit_cast(unsigned, b); }
__device__ __forceinline__ float bf_lo(unsigned w) { return __uint_as_float(w << 16); }
__device__ __forceinline__ float bf_hi(unsigned w) { return __uint_as_float(w & 0xffff0000u); }
__device__ __forceinline__ u32x4 pk8(f32x4 a, f32x4 b) { u32x4 w; w.x = pk_bf16(a[0], a[1]); w.y = pk_bf16(a[2], a[3]); w.z = pk_bf16(b[0], b[1]); w.w = pk_bf16(b[2], b[3]); return w; }

struct EpiInProj {
    static constexpr bool PERM = true, AFTER_DRAIN = false;
    bf16_t* U; float* AUX; float qscale;
    __device__ __forceinline__ void operator()(const f32x4 (&acc)[2][2][4][2], const Unit& u, int wr, int wc, int fr, int fq) const {
        const int row0 = u.pm * BM + wr * 64 + fr;
        if (u.pn < 22) {
            const float sc = (u.pn < 4) ? qscale : 1.f;
            const int col0 = u.pn * BM + wc * 32 + 8 * fq;
#pragma unroll
            for (int ai = 0; ai < 2; ++ai)
#pragma unroll
                for (int m = 0; m < 4; ++m) { bf16_t* rowp = U + (size_t)(row0 + ai * HALF + m * 16) * 5632 + col0;
#pragma unroll
                    for (int bj = 0; bj < 2; ++bj) *(u32x4*)(rowp + bj * HALF) = pk8(acc[ai][bj][m][0] * sc, acc[ai][bj][m][1] * sc); }
        } else if (wc == 0) {
#pragma unroll
            for (int ai = 0; ai < 2; ++ai)
#pragma unroll
                for (int m = 0; m < 4; ++m) { float* rp = AUX + (size_t)(row0 + ai * HALF + m * 16) * 32 + 8 * fq;
                    *(f32x4*)rp = acc[ai][0][m][0]; *(f32x4*)(rp + 4) = acc[ai][0][m][1]; }
        }
    }
};
struct EpiPlainBf16 {
    static constexpr bool PERM = true, AFTER_DRAIN = false;
    bf16_t* O; int ldc;
    __device__ __forceinline__ void operator()(const f32x4 (&acc)[2][2][4][2], const Unit& u, int wr, int wc, int fr, int fq) const {
        const int row0 = u.pm * BM + wr * 64 + fr; const int col0 = u.pn * BM + wc * 32 + 8 * fq;
#pragma unroll
        for (int ai = 0; ai < 2; ++ai)
#pragma unroll
            for (int m = 0; m < 4; ++m) { bf16_t* rowp = O + (size_t)(row0 + ai * HALF + m * 16) * ldc + col0;
#pragma unroll
                for (int bj = 0; bj < 2; ++bj) *(u32x4*)(rowp + bj * HALF) = pk8(acc[ai][bj][m][0], acc[ai][bj][m][1]); }
    }
};
struct EpiRowScaleBf16 {
    static constexpr bool PERM = true, AFTER_DRAIN = false;
    bf16_t* O; int ldc; const float* rowsq;
    __device__ __forceinline__ void operator()(const f32x4 (&acc)[2][2][4][2], const Unit& u, int wr, int wc, int fr, int fq) const {
        const int row0 = u.pm * BM + wr * 64 + fr; const int col0 = u.pn * BM + wc * 32 + 8 * fq;
#pragma unroll
        for (int ai = 0; ai < 2; ++ai)
#pragma unroll
            for (int m = 0; m < 4; ++m) { const int row = row0 + ai * HALF + m * 16; const float rs = 1.0f / sqrtf(rowsq[row] * (1.0f / 2048.0f) + 1e-6f);
                bf16_t* rowp = O + (size_t)row * ldc + col0;
#pragma unroll
                for (int bj = 0; bj < 2; ++bj) *(u32x4*)(rowp + bj * HALF) = pk8(acc[ai][bj][m][0] * rs, acc[ai][bj][m][1] * rs); }
    }
};
template <int MODE> struct EpiRes {
    static constexpr bool PERM = true, AFTER_DRAIN = false;
    const float* base; float* out; bf16_t* XW; const float* nw; float* rowsq_out; const float* rowsq_in; const bf16_t* PP;
    __device__ __forceinline__ void operator()(const f32x4 (&acc)[2][2][4][2], const Unit& u, int wr, int wc, int fr, int fq) const {
        const int row0 = u.pm * BM + wr * 64 + fr; const int col0 = u.pn * BM + wc * 32 + 8 * fq;
        f32x4 nwv[2][2];
#pragma unroll
        for (int bj = 0; bj < 2; ++bj)
#pragma unroll
            for (int n = 0; n < 2; ++n) nwv[bj][n] = (MODE != 2) ? *(const f32x4*)(nw + col0 + bj * HALF + 4 * n) : (f32x4){0.f, 0.f, 0.f, 0.f};
#pragma unroll
        for (int ai = 0; ai < 2; ++ai)
#pragma unroll
            for (int m = 0; m < 4; ++m) {
                const int row = row0 + ai * HALF + m * 16; const size_t off = (size_t)row * 2048 + col0;
                float rs = 0.f; if (MODE == 2) rs = 1.0f / sqrtf(rowsq_in[row] * (1.0f / 2048.0f) + 1e-6f);
                float ss = 0.f;
#pragma unroll
                for (int bj = 0; bj < 2; ++bj) {
                    const f32x4 b0 = *(const f32x4*)(base + off + bj * HALF), b1 = *(const f32x4*)(base + off + bj * HALF + 4);
                    f32x4 a0 = acc[ai][bj][m][0], a1 = acc[ai][bj][m][1];
                    if (MODE == 2) {
                        const u32x4 pw = *(const u32x4*)(PP + off + bj * HALF);
                        const f32x4 p0 = {bf_lo(pw.x), bf_hi(pw.x), bf_lo(pw.y), bf_hi(pw.y)}, p1 = {bf_lo(pw.z), bf_hi(pw.z), bf_lo(pw.w), bf_hi(pw.w)};
#pragma unroll
                        for (int i = 0; i < 4; ++i) { a0[i] = p0[i] / (1.0f + __expf(-rs * a0[i])); a1[i] = p1[i] / (1.0f + __expf(-rs * a1[i])); }
                    }
                    const f32x4 x0 = b0 + a0, x1 = b1 + a1;
                    *(f32x4*)(out + off + bj * HALF) = x0; *(f32x4*)(out + off + bj * HALF + 4) = x1;
                    ss += (x0[0] * x0[0] + x0[1] * x0[1]) + (x0[2] * x0[2] + x0[3] * x0[3]) + (x1[0] * x1[0] + x1[1] * x1[1]) + (x1[2] * x1[2] + x1[3] * x1[3]);
                    if (MODE != 2) *(u32x4*)(XW + off + bj * HALF) = pk8(x0 * nwv[bj][0], x1 * nwv[bj][1]);
                }
                ss += __shfl_xor(ss, 16); ss += __shfl_xor(ss, 32);
                if (fq == 0) unsafeAtomicAdd(rowsq_out + row, ss);
            }
    }
};
}

using pg8::bf16_t; using pg8::bf16x8; using pg8::f32x4; using pg8::u32x4; using pg8::pk_bf16; using pg8::pk8; using pg8::bf_lo; using pg8::bf_hi;
typedef float f32x16 __attribute__((ext_vector_type(16)));
typedef unsigned u32x2 __attribute__((ext_vector_type(2)));
typedef short s16x4 __attribute__((ext_vector_type(4)));
constexpr int SEQ = 8192, DM = 2048, UP = 5632, NIN = 5888, DFF = 5632, GUP = 11264;
constexpr float LOG2E = 1.4426950408889634f;
constexpr float QSCALE = 0.125f * LOG2E;
constexpr size_t MiB = 1u << 20;
constexpr size_t WS_RS1 = 0, WS_RS2 = 32768, WS_RS3 = 65536, WS_RSS = 98304, WS_CD = 131072, WS_CL = 262144, WS_AUX = 1 * MiB;
constexpr size_t WS_WGU = 4 * MiB, WS_WD = 48 * MiB, WS_WPG = 70 * MiB, WS_WPP = 78 * MiB, WS_XW = 79 * MiB, WS_PP = 111 * MiB;
constexpr size_t WS_WIN = 143 * MiB, WS_WOUT = 166 * MiB, WS_P16 = 174 * MiB, WS_U = 178 * MiB, WS_VT = 266 * MiB, WS_ST = 282 * MiB, WS_YC = 314 * MiB, WS_GU = 143 * MiB;
constexpr size_t WS_END = 346 * MiB;
constexpr int LDS_BYTES = 147456;
constexpr int NTHREADS = 512;

__device__ __forceinline__ float bf2f(bf16_t b) { return __uint_as_float((unsigned)b << 16); }
__device__ __forceinline__ bf16_t f2bf(float f) { return (bf16_t)(pk_bf16(f, 0.f) & 0xffffu); }
__device__ __forceinline__ float s2f(short s) { return __uint_as_float(((unsigned)(unsigned short)s) << 16); }
__device__ __forceinline__ float wave_sum(float v) {
#pragma unroll
    for (int o = 1; o < 64; o <<= 1) v += __shfl_xor(v, o);
    return v;
}
#define LDS_WAIT() asm volatile("s_waitcnt lgkmcnt(0)" ::: "memory")

__device__ __forceinline__ int inproj_src(int np) { if (np < 3072) return np; if (np < 5632) return np + 16; if (np < 5648) return 3072 + (np - 5632); if (np < 5664) return np; return -1; }

template <bool MAP> __device__ __forceinline__ void transpose_item(const float* __restrict__ W, int K, int N, int ND, bf16_t* WT, float* scr, int item, int lane) {
    const int nblk = ND / 32, kb = item / nblk, nb = item % nblk, k0 = 64 * kb, n0 = 32 * nb;
    int src = n0 + (lane & 31); if (MAP) src = inproj_src(src);
#pragma unroll 8
    for (int i = 0; i < 32; ++i) { const int kk = 2 * i + (lane >> 5); scr[kk * 33 + (lane & 31)] = (src >= 0) ? W[(size_t)(k0 + kk) * N + src] : 0.f; }
    LDS_WAIT();
    const int c = lane & 7;
#pragma unroll
    for (int j = 0; j < 4; ++j) { const int n = (lane >> 3) + 8 * j; const float* s = scr + (8 * c) * 33 + n;
        u32x4 o; o.x = pk_bf16(s[0 * 33], s[1 * 33]); o.y = pk_bf16(s[2 * 33], s[3 * 33]); o.z = pk_bf16(s[4 * 33], s[5 * 33]); o.w = pk_bf16(s[6 * 33], s[7 * 33]);
        *(u32x4*)(WT + (size_t)(n0 + n) * K + k0 + 8 * c) = o; }
    LDS_WAIT();
}
__device__ __forceinline__ void rms_row_to_bf16(const float* __restrict__ xrow, const float* __restrict__ w, bf16_t* orow, int lane) {
    const f32x4* xr = (const f32x4*)xrow + lane; const f32x4* wr = (const f32x4*)w + lane;
    f32x4 v[8]; float s = 0.f;
#pragma unroll
    for (int j = 0; j < 8; ++j) { v[j] = xr[64 * j]; s += (v[j].x * v[j].x + v[j].y * v[j].y) + (v[j].z * v[j].z + v[j].w * v[j].w); }
    const float rstd = 1.0f / sqrtf(wave_sum(s) * (1.0f / 2048.0f) + 1e-6f);
    u32x2* o8 = (u32x2*)orow + lane;
#pragma unroll
    for (int j = 0; j < 8; ++j) { const f32x4 wv = wr[64 * j]; u32x2 o; o.x = pk_bf16(v[j].x * rstd * wv.x, v[j].y * rstd * wv.y); o.y = pk_bf16(v[j].z * rstd * wv.z, v[j].w * rstd * wv.w); o8[64 * j] = o; }
}
__device__ __forceinline__ void conv4_silu8(const bf16_t* __restrict__ U, int t, int ch, const float* __restrict__ cw, const float* __restrict__ cb, f32x4& o0, f32x4& o1) {
    f32x4 a0 = *(const f32x4*)(cb + ch), a1 = *(const f32x4*)(cb + ch + 4);
#pragma unroll
    for (int k = 0; k < 4; ++k) { const int tt = t - 3 + k;
        if (tt >= 0) { const u32x4 v = *(const u32x4*)(U + (size_t)tt * UP + 3072 + ch); const f32x4 w0 = *(const f32x4*)(cw + k * 1536 + ch), w1 = *(const f32x4*)(cw + k * 1536 + ch + 4);
            a0[0] += w0[0] * bf_lo(v.x); a0[1] += w0[1] * bf_hi(v.x); a0[2] += w0[2] * bf_lo(v.y); a0[3] += w0[3] * bf_hi(v.y);
            a1[0] += w1[0] * bf_lo(v.z); a1[1] += w1[1] * bf_hi(v.z); a1[2] += w1[2] * bf_lo(v.w); a1[3] += w1[3] * bf_hi(v.w); } }
#pragma unroll
    for (int i = 0; i < 4; ++i) { a0[i] = a0[i] / (1.0f + __expf(-a0[i])); a1[i] = a1[i] / (1.0f + __expf(-a1[i])); }
    o0 = a0; o1 = a1;
}
__device__ __forceinline__ int crow(int r, int hi) { return (r & 3) + 8 * (r >> 2) + 4 * hi; }

constexpr int AT_K = 0, AT_V = 18432, AT_C = 36864;
__device__ __forceinline__ void fox_unit(unsigned char* lds, const bf16_t* __restrict__ U, const bf16_t* __restrict__ Vt, const float* __restrict__ CL, bf16_t* YC, int h, int qb) {
    const int tid = threadIdx.x, lane = tid & 63, r32 = lane & 31, hi = lane >> 5; const int wid = __builtin_amdgcn_readfirstlane(tid >> 6);
    const int q0 = qb * 256, qrow = q0 + wid * 32 + r32, qfirst = q0 + wid * 32;
    bf16x8 qr[4];
#pragma unroll
    for (int d0 = 0; d0 < 4; ++d0) qr[d0] = *(const bf16x8*)(U + (size_t)qrow * UP + h * 64 + d0 * 16 + hi * 8);
    const float cq = CL[h * SEQ + qrow];
    const int NT = 4 * (qb + 1);
    const int lrow = tid >> 3, lck = tid & 7;
    const bf16_t* ksrc = U + (size_t)lrow * UP + 1024 + h * 64 + lck * 8;
    const bf16_t* vsrc = Vt + (size_t)(h * 64 + lrow) * SEQ + lck * 8;
    const float* csrc = CL + h * SEQ + (tid & 15) * 4;
    const int ldoff = (lrow * 72 + lck * 8) * 2;
    u32x4 kreg, vreg; f32x4 creg = {0.f, 0.f, 0.f, 0.f};
    kreg = *(const u32x4*)ksrc; vreg = *(const u32x4*)vsrc; if (tid < 16) creg = *(const f32x4*)csrc;
    *(u32x4*)(lds + AT_K + ldoff) = kreg; *(u32x4*)(lds + AT_V + ldoff) = vreg; if (tid < 16) *(f32x4*)(lds + AT_C + tid * 16) = creg;
    __syncthreads();
    float mrun = -INFINITY, lrun = 0.f;
    f32x16 o0 = {}, o1 = {};
    for (int t = 0; t < NT; ++t) {
        const int cur = t & 1;
        if (t + 1 < NT) { kreg = *(const u32x4*)(ksrc + (size_t)(t + 1) * 64 * UP); vreg = *(const u32x4*)(vsrc + (t + 1) * 64); if (tid < 16) creg = *(const f32x4*)(csrc + (t + 1) * 64); }
        if (64 * t <= qfirst + 31) {
            const unsigned char* Kb = lds + AT_K + cur * 9216; const unsigned char* Vb = lds + AT_V + cur * 9216; const float* Cb = (const float*)(lds + AT_C + cur * 256);
            f32x16 p0, p1;
#pragma unroll
            for (int g = 0; g < 4; ++g) { const f32x4 c0 = *(const f32x4*)(Cb + 8 * g + 4 * hi), c1 = *(const f32x4*)(Cb + 32 + 8 * g + 4 * hi);
#pragma unroll
                for (int i = 0; i < 4; ++i) { p0[4 * g + i] = cq - c0[i]; p1[4 * g + i] = cq - c1[i]; } }
#pragma unroll
            for (int d0 = 0; d0 < 4; ++d0) {
                const bf16x8 a0 = *(const bf16x8*)(Kb + (r32 * 72 + d0 * 16 + hi * 8) * 2);
                const bf16x8 a1 = *(const bf16x8*)(Kb + ((32 + r32) * 72 + d0 * 16 + hi * 8) * 2);
                p0 = __builtin_amdgcn_mfma_f32_32x32x16_bf16(a0, qr[d0], p0, 0, 0, 0);
                p1 = __builtin_amdgcn_mfma_f32_32x32x16_bf16(a1, qr[d0], p1, 0, 0, 0);
            }
            if (64 * t + 63 > qfirst) {
#pragma unroll
                for (int r = 0; r < 16; ++r) { const int kv = 64 * t + crow(r, hi); if (kv > qrow) p0[r] = -INFINITY; if (kv + 32 > qrow) p1[r] = -INFINITY; }
            }
            float rm = fmaxf(p0[0], p1[0]);
#pragma unroll
            for (int r = 1; r < 16; ++r) rm = fmaxf(rm, fmaxf(p0[r], p1[r]));
            rm = fmaxf(rm, __shfl_xor(rm, 32));
            const float mnew = fmaxf(mrun, rm); const float alpha = __builtin_amdgcn_exp2f(mrun - mnew); mrun = mnew;
            float ls = 0.f;
#pragma unroll
            for (int r = 0; r < 16; ++r) { p0[r] = __builtin_amdgcn_exp2f(p0[r] - mnew); p1[r] = __builtin_amdgcn_exp2f(p1[r] - mnew); ls += p0[r] + p1[r]; }
            lrun = lrun * alpha + ls;
#pragma unroll
            for (int r = 0; r < 16; ++r) { o0[r] *= alpha; o1[r] *= alpha; }
#pragma unroll
            for (int b = 0; b < 2; ++b)
#pragma unroll
                for (int s = 0; s < 2; ++s) {
                    u32x4 pw;
                    if (b == 0) { pw.x = pk_bf16(p0[8 * s + 0], p0[8 * s + 1]); pw.y = pk_bf16(p0[8 * s + 2], p0[8 * s + 3]); pw.z = pk_bf16(p0[8 * s + 4], p0[8 * s + 5]); pw.w = pk_bf16(p0[8 * s + 6], p0[8 * s + 7]); }
                    else        { pw.x = pk_bf16(p1[8 * s + 0], p1[8 * s + 1]); pw.y = pk_bf16(p1[8 * s + 2], p1[8 * s + 3]); pw.z = pk_bf16(p1[8 * s + 4], p1[8 * s + 5]); pw.w = pk_bf16(p1[8 * s + 6], p1[8 * s + 7]); }
                    const bf16x8 pb = __builtin_bit_cast(bf16x8, pw);
                    const int kvo = 32 * b + 16 * s + 4 * hi;
                    {   const u32x2 v0 = *(const u32x2*)(Vb + (r32 * 72 + kvo) * 2), v1 = *(const u32x2*)(Vb + (r32 * 72 + kvo + 8) * 2);
                        const u32x4 vv = {v0.x, v0.y, v1.x, v1.y}; o0 = __builtin_amdgcn_mfma_f32_32x32x16_bf16(__builtin_bit_cast(bf16x8, vv), pb, o0, 0, 0, 0); }
                    {   const u32x2 v0 = *(const u32x2*)(Vb + ((32 + r32) * 72 + kvo) * 2), v1 = *(const u32x2*)(Vb + ((32 + r32) * 72 + kvo + 8) * 2);
                        const u32x4 vv = {v0.x, v0.y, v1.x, v1.y}; o1 = __builtin_amdgcn_mfma_f32_32x32x16_bf16(__builtin_bit_cast(bf16x8, vv), pb, o1, 0, 0, 0); }
                }
        }
        if (t + 1 < NT) { const int nb = (cur ^ 1); *(u32x4*)(lds + AT_K + nb * 9216 + ldoff) = kreg; *(u32x4*)(lds + AT_V + nb * 9216 + ldoff) = vreg; if (tid < 16) *(f32x4*)(lds + AT_C + nb * 256 + tid * 16) = creg; }
        __syncthreads();
    }
    lrun += __shfl_xor(lrun, 32);
    const float inv = 1.0f / lrun;
    bf16_t* orow = YC + (size_t)qrow * 2048 + h * 64 + 4 * hi;
#pragma unroll
    for (int g = 0; g < 4; ++g) {
        u32x2 w0, w1;
        w0.x = pk_bf16(o0[4 * g] * inv, o0[4 * g + 1] * inv); w0.y = pk_bf16(o0[4 * g + 2] * inv, o0[4 * g + 3] * inv);
        w1.x = pk_bf16(o1[4 * g] * inv, o1[4 * g + 1] * inv); w1.y = pk_bf16(o1[4 * g + 2] * inv, o1[4 * g + 3] * inv);
        *(u32x2*)(orow + 8 * g) = w0; *(u32x2*)(orow + 32 + 8 * g) = w1;
    }
}

constexpr int SL_XT = 0;
constexpr int SL_CM = 73728;
constexpr int SL_BM = 91136;
constexpr int SL_GG = 108544;
constexpr int SL_DT = 125952, SL_AC = 128000, SL_SW = 130048;

#ifndef PHMASK
#define PHMASK 0xFFFF
#endif
#define PH(n) ((PHMASK >> (n)) & 1)
struct Params { const float* in[21]; float* out; unsigned char* ws; };

__device__ __forceinline__ void ssd_stage_xt_dt(unsigned char* lds, const bf16_t* U, const float* AUX, const float* cw, const float* cb, float dtb, float Ah, int t0, int h, int wave, int lane, float& dt_out, float& ac_out) {
    bf16_t* XT = (bf16_t*)(lds + SL_XT + wave * 9216);
#pragma unroll 2
    for (int it = 0; it < 8; ++it) { const int idx = it * 64 + lane, s = idx >> 3, ck = idx & 7; f32x4 a0, a1; conv4_silu8(U, t0 + s, h * 64 + ck * 8, cw, cb, a0, a1);
#pragma unroll
        for (int i = 0; i < 4; ++i) { XT[(ck * 8 + i) * 72 + s] = f2bf(a0[i]); XT[(ck * 8 + 4 + i) * 72 + s] = f2bf(a1[i]); } }
    const float xr = AUX[(size_t)(t0 + lane) * 32 + 16 + h] + dtb;
    const float dt = (xr > 20.f) ? xr : log1pf(expf(xr));
    float ac = dt * Ah;
#pragma unroll
    for (int o = 1; o < 64; o <<= 1) { const float n = __shfl_up(ac, o); if (lane >= o) ac += n; }
    dt_out = dt; ac_out = ac;
}

__global__ void __launch_bounds__(NTHREADS, 2) fwd_megakernel(Params P) {
    extern __shared__ __attribute__((aligned(16))) unsigned char lds[];
    cg::grid_group grid = cg::this_grid();
    const int G = gridDim.x, bid = blockIdx.x, nthr = G * NTHREADS;
#define TVARS int tid = threadIdx.x; asm volatile("" : "+v"(tid)); const int lane = tid & 63, wave = __builtin_amdgcn_readfirstlane(tid >> 6), quad = lane >> 4, l15 = lane & 15, gtid = bid * NTHREADS + tid; (void)quad; (void)l15; (void)gtid; (void)wave; (void)lane;
    unsigned char* ws = P.ws;
    const float* x = P.in[0]; float* out = P.out;
    float* RS1 = (float*)(ws + WS_RS1); float* RS2 = (float*)(ws + WS_RS2); float* RS3 = (float*)(ws + WS_RS3); float* RSS = (float*)(ws + WS_RSS);
    float* CD = (float*)(ws + WS_CD); float* CL = (float*)(ws + WS_CL); float* AUX = (float*)(ws + WS_AUX);
    bf16_t* Wgu_t = (bf16_t*)(ws + WS_WGU); bf16_t* Wd_t = (bf16_t*)(ws + WS_WD); bf16_t* Wpg_t = (bf16_t*)(ws + WS_WPG); bf16_t* Wpp_t = (bf16_t*)(ws + WS_WPP);
    bf16_t* XW = (bf16_t*)(ws + WS_XW); bf16_t* PP = (bf16_t*)(ws + WS_PP); bf16_t* Win_t = (bf16_t*)(ws + WS_WIN); bf16_t* Wout_t = (bf16_t*)(ws + WS_WOUT);
    bf16_t* P16 = (bf16_t*)(ws + WS_P16); bf16_t* U = (bf16_t*)(ws + WS_U); bf16_t* Vt = (bf16_t*)(ws + WS_VT); bf16_t* ST = (bf16_t*)(ws + WS_ST);
    bf16_t* YC = (bf16_t*)(ws + WS_YC); bf16_t* GU = (bf16_t*)(ws + WS_GU);
    __attribute__((address_space(3))) unsigned char* glds = (__attribute__((address_space(3))) unsigned char*)lds;

    if (PH(0)) { TVARS
        float* scr = (float*)(lds + wave * 16384);
        const int gw = bid * 8 + wave, NGW = G * 8;
        constexpr int I_IN = 32 * 184, I_OUT = 32 * 64, I_GU = 32 * 352, I_D = 88 * 64, I_PG = 32 * 64, I_PP = 4 * 64;
        constexpr int NITEMS = I_IN + I_OUT + I_GU + I_D + I_PG + I_PP;
        for (int it = gw; it < NITEMS; it += NGW) {
            int r = it;
            if (r < I_IN) { transpose_item<true>(P.in[3], 2048, 5664, NIN, Win_t, scr, r, lane); continue; } r -= I_IN;
            if (r < I_OUT) { transpose_item<false>(P.in[11], 2048, 2048, 2048, Wout_t, scr, r, lane); continue; } r -= I_OUT;
            if (r < I_GU) { transpose_item<false>(P.in[13], 2048, GUP, GUP, Wgu_t, scr, r, lane); continue; } r -= I_GU;
            if (r < I_D) { transpose_item<false>(P.in[16], DFF, 2048, 2048, Wd_t, scr, r, lane); continue; } r -= I_D;
            if (r < I_PG) { transpose_item<false>(P.in[18], 2048, 2048, 2048, Wpg_t, scr, r, lane); continue; } r -= I_PG;
            transpose_item<false>(P.in[19], 256, 2048, 2048, Wpp_t, scr, r, lane);
        }
        for (int m = gw; m < SEQ; m += NGW) rms_row_to_bf16(x + (size_t)m * DM, P.in[2], XW + (size_t)m * DM, lane);
        const float* pin = P.in[1];
        for (int i = gtid; i < SEQ * 256 / 8; i += nthr) { const f32x4 a = *(const f32x4*)(pin + (size_t)i * 8), b = *(const f32x4*)(pin + (size_t)i * 8 + 4); *(u32x4*)(P16 + (size_t)i * 8) = pk8(a, b); }
        for (int i = gtid; i < 4 * SEQ; i += nthr) RS1[i] = 0.f;
    }
    grid.sync();

    if (PH(1)) {
        pg8::Gemm g{XW, Win_t, SEQ, NIN, DM, DM}; pg8::StaticOrder S; S.init(SEQ, NIN, G, bid);
        pg8::EpiInProj E{U, AUX, QSCALE};
        pg8::gemm_phase<pg8::EpiInProj, pg8::StaticOrder, true, true>(glds, g, S, E);
    }
    if (PH(13)) {
        int kpp = 256; asm volatile("" : "+s"(kpp));
        pg8::Gemm g{P16, Wpp_t, SEQ, DM, kpp, kpp}; pg8::StaticOrder S; S.init(SEQ, DM, G, bid);
        pg8::EpiPlainBf16 E{PP, DM};
        pg8::gemm_phase<pg8::EpiPlainBf16, pg8::StaticOrder, true, true>(glds, g, S, E);
    }
    grid.sync();

    if (PH(2)) for (int h = bid; h < 16; h += G) { TVARS
        float* wsum = (float*)(lds + 140000);
        const float bfh = P.in[4][h]; const int t0 = tid * 16;
        float run = 0.f; float loc[16];
#pragma unroll
        for (int i = 0; i < 16; ++i) { const float xv = AUX[(size_t)(t0 + i) * 32 + h] + bfh; const float ls = fminf(xv, 0.f) - log1pf(expf(-fabsf(xv))); run += ls; loc[i] = run; }
        float incl = run;
#pragma unroll
        for (int o = 1; o < 64; o <<= 1) { const float n = __shfl_up(incl, o); if (lane >= o) incl += n; }
        if (lane == 63) wsum[wave] = incl;
        __syncthreads();
        float pre = 0.f;
#pragma unroll
        for (int w = 0; w < 8; ++w) { const float v = wsum[w]; if (w < wave) pre += v; }
        const float excl = pre + incl - run;
#pragma unroll
        for (int i = 0; i < 16; ++i) CL[h * SEQ + t0 + i] = (excl + loc[i]) * LOG2E;
        __syncthreads();
    }
    if (PH(2)) for (int it = bid; it < 2048; it += G) { TVARS
        const int h = it >> 7, tb = it & 127; bf16_t* tileT = (bf16_t*)(lds + 4096);
        const int row = tid >> 3, ck = tid & 7;
        const u32x4 v = *(const u32x4*)(U + (size_t)(tb * 64 + row) * UP + 2048 + h * 64 + ck * 8);
        tileT[(ck * 8 + 0) * 72 + row] = (bf16_t)(v.x & 0xffff); tileT[(ck * 8 + 1) * 72 + row] = (bf16_t)(v.x >> 16);
        tileT[(ck * 8 + 2) * 72 + row] = (bf16_t)(v.y & 0xffff); tileT[(ck * 8 + 3) * 72 + row] = (bf16_t)(v.y >> 16);
        tileT[(ck * 8 + 4) * 72 + row] = (bf16_t)(v.z & 0xffff); tileT[(ck * 8 + 5) * 72 + row] = (bf16_t)(v.z >> 16);
        tileT[(ck * 8 + 6) * 72 + row] = (bf16_t)(v.w & 0xffff); tileT[(ck * 8 + 7) * 72 + row] = (bf16_t)(v.w >> 16);
        __syncthreads();
        const u32x4 o = *(const u32x4*)(tileT + row * 72 + ck * 8);
        *(u32x4*)(Vt + (size_t)(h * 64 + row) * SEQ + tb * 64 + ck * 8) = o;
        __syncthreads();
    }
    if (PH(2)) { TVARS
        const float* cw = P.in[5]; const float* cb = P.in[6];
        for (int it = bid; it < 256; it += G) {
            const int c = it >> 1, g = it & 1, t0 = c * 64, h = g * 8 + wave;
            bf16_t* BMT = (bf16_t*)(lds + SL_CM);
            for (int idx = tid; idx < 1024; idx += NTHREADS) { const int s = idx >> 4, ck = idx & 15; f32x4 a0, a1; conv4_silu8(U, t0 + s, 1024 + g * 128 + ck * 8, cw, cb, a0, a1);
#pragma unroll
                for (int i = 0; i < 4; ++i) { BMT[(ck * 8 + i) * 72 + s] = f2bf(a0[i]); BMT[(ck * 8 + 4 + i) * 72 + s] = f2bf(a1[i]); } }
            float dt, ac; const float Ah = -expf(P.in[8][h]);
            ssd_stage_xt_dt(lds, U, AUX, cw, cb, P.in[7][h], Ah, t0, h, wave, lane, dt, ac);
            const float ac63 = __shfl(ac, 63);
            float* SW = (float*)(lds + SL_SW + wave * 256);
            SW[lane] = expf(ac63 - ac) * dt;
            if (lane == 0) CD[c * 16 + h] = expf(ac63);
            __syncthreads();
            const bf16_t* XT = (const bf16_t*)(lds + SL_XT + wave * 9216);
            for (int pt = 0; pt < 4; ++pt) {
                bf16x8 af[2];
#pragma unroll
                for (int ks = 0; ks < 2; ++ks) { const bf16x8 xa = *(const bf16x8*)(XT + (pt * 16 + l15) * 72 + ks * 32 + quad * 8);
                    const f32x4 w0 = *(const f32x4*)(SW + ks * 32 + quad * 8), w1 = *(const f32x4*)(SW + ks * 32 + quad * 8 + 4);
                    u32x4 pw; pw.x = pk_bf16(s2f(xa[0]) * w0[0], s2f(xa[1]) * w0[1]); pw.y = pk_bf16(s2f(xa[2]) * w0[2], s2f(xa[3]) * w0[3]);
                    pw.z = pk_bf16(s2f(xa[4]) * w1[0], s2f(xa[5]) * w1[1]); pw.w = pk_bf16(s2f(xa[6]) * w1[2], s2f(xa[7]) * w1[3]);
                    af[ks] = __builtin_bit_cast(bf16x8, pw); }
                f32x4 acc[8];
#pragma unroll
                for (int nt = 0; nt < 8; ++nt) { acc[nt] = (f32x4){0.f, 0.f, 0.f, 0.f};
#pragma unroll
                    for (int ks = 0; ks < 2; ++ks) { const bf16x8 b = *(const bf16x8*)(BMT + (nt * 16 + l15) * 72 + ks * 32 + quad * 8);
                        acc[nt] = __builtin_amdgcn_mfma_f32_16x16x32_bf16(af[ks], b, acc[nt], 0, 0, 0); } }
#pragma unroll
                for (int nt = 0; nt < 8; ++nt)
#pragma unroll
                    for (int r = 0; r < 4; ++r) ST[((size_t)(c * 16 + h) * 64 + pt * 16 + quad * 4 + r) * 128 + nt * 16 + l15] = f2bf(acc[nt][r]);
            }
            __syncthreads();
        }
    }
    grid.sync();

    if (PH(3)) { TVARS for (int e = gtid; e < 131072; e += nthr) {
        const int h = e >> 13; float run = 0.f;
        for (int c0 = 0; c0 < 128; c0 += 8) {
            float sv[8], dv[8];
#pragma unroll
            for (int j = 0; j < 8; ++j) { sv[j] = bf2f(ST[(size_t)(c0 + j) * 131072 + e]); dv[j] = CD[(c0 + j) * 16 + h]; }
#pragma unroll
            for (int j = 0; j < 8; ++j) { ST[(size_t)(c0 + j) * 131072 + e] = f2bf(run); run = run * dv[j] + sv[j]; }
        }
    } }
    grid.sync();

    { TVARS
        const float* cw = P.in[5]; const float* cb = P.in[6]; const float* nw = P.in[10];
        if (PH(4)) for (int it = bid; it < 256; it += G) {
            const int c = it >> 1, g = it & 1, t0 = c * 64, h = g * 8 + wave;
            bf16_t* CM = (bf16_t*)(lds + SL_CM); bf16_t* BM = (bf16_t*)(lds + SL_BM); float* GG = (float*)(lds + SL_GG);
            for (int idx = tid; idx < 2048; idx += NTHREADS) { const int which = idx >> 10, s = (idx >> 4) & 63, ck = idx & 15; f32x4 a0, a1;
                conv4_silu8(U, t0 + s, 1024 + which * 256 + g * 128 + ck * 8, cw, cb, a0, a1);
                *(u32x4*)((which ? CM : BM) + s * 136 + ck * 8) = pk8(a0, a1); }
            float dt, ac; const float Ah = -expf(P.in[8][h]);
            ssd_stage_xt_dt(lds, U, AUX, cw, cb, P.in[7][h], Ah, t0, h, wave, lane, dt, ac);
            float* SDT = (float*)(lds + SL_DT + wave * 256); float* SAC = (float*)(lds + SL_AC + wave * 256);
            SDT[lane] = dt; SAC[lane] = ac;
            __syncthreads();
#pragma unroll
            for (int k2 = 0; k2 < 2; ++k2) { const int id = 2 * wave + k2, lt = id >> 2, st = id & 3; f32x4 acc = {0.f, 0.f, 0.f, 0.f};
#pragma unroll
                for (int ks = 0; ks < 4; ++ks) { const bf16x8 a = *(const bf16x8*)(CM + (lt * 16 + l15) * 136 + ks * 32 + quad * 8), b = *(const bf16x8*)(BM + (st * 16 + l15) * 136 + ks * 32 + quad * 8);
                    acc = __builtin_amdgcn_mfma_f32_16x16x32_bf16(a, b, acc, 0, 0, 0); }
#pragma unroll
                for (int r = 0; r < 4; ++r) GG[(lt * 16 + quad * 4 + r) * 68 + st * 16 + l15] = acc[r]; }
            __syncthreads();
            const bf16_t* XT = (const bf16_t*)(lds + SL_XT + wave * 9216);
            const float Dh = P.in[9][h];
            const bf16_t* HP = ST + (size_t)(c * 16 + h) * 64 * 128;
            for (int lt = 0; lt < 4; ++lt) {
                const int la = lt * 16 + l15; const float acl = SAC[la];
                f32x4 yd[4], yo[4];
#pragma unroll
                for (int pt = 0; pt < 4; ++pt) { yd[pt] = (f32x4){0.f, 0.f, 0.f, 0.f}; yo[pt] = (f32x4){0.f, 0.f, 0.f, 0.f}; }
#pragma unroll
                for (int ks = 0; ks < 2; ++ks) {
                    if (ks * 32 <= lt * 16 + 15) {
                        const int s0 = ks * 32 + quad * 8;
                        const f32x4 g0 = *(const f32x4*)(GG + la * 68 + s0), g1 = *(const f32x4*)(GG + la * 68 + s0 + 4);
                        const f32x4 e0 = *(const f32x4*)(SAC + s0), e1 = *(const f32x4*)(SAC + s0 + 4), d0 = *(const f32x4*)(SDT + s0), d1 = *(const f32x4*)(SDT + s0 + 4);
                        float mv[8];
#pragma unroll
                        for (int j = 0; j < 4; ++j) { mv[j] = (s0 + j <= la) ? g0[j] * __expf(fminf(acl - e0[j], 0.f)) * d0[j] : 0.f; mv[4 + j] = (s0 + 4 + j <= la) ? g1[j] * __expf(fminf(acl - e1[j], 0.f)) * d1[j] : 0.f; }
                        u32x4 pw; pw.x = pk_bf16(mv[0], mv[1]); pw.y = pk_bf16(mv[2], mv[3]); pw.z = pk_bf16(mv[4], mv[5]); pw.w = pk_bf16(mv[6], mv[7]);
                        const bf16x8 a = __builtin_bit_cast(bf16x8, pw);
#pragma unroll
                        for (int pt = 0; pt < 4; ++pt) { const bf16x8 b = *(const bf16x8*)(XT + (pt * 16 + l15) * 72 + s0); yd[pt] = __builtin_amdgcn_mfma_f32_16x16x32_bf16(a, b, yd[pt], 0, 0, 0); }
                    }
                }
#pragma unroll
                for (int ks = 0; ks < 4; ++ks) { const bf16x8 a = *(const bf16x8*)(CM + la * 136 + ks * 32 + quad * 8);
#pragma unroll
                    for (int pt = 0; pt < 4; ++pt) { const bf16x8 b = *(const bf16x8*)(HP + (size_t)(pt * 16 + l15) * 128 + ks * 32 + quad * 8); yo[pt] = __builtin_amdgcn_mfma_f32_16x16x32_bf16(a, b, yo[pt], 0, 0, 0); } }
                const int lc = lt * 16 + quad * 4;
                const f32x4 eav = *(const f32x4*)(SAC + lc);
                float ea[4], rsum[4];
#pragma unroll
                for (int r = 0; r < 4; ++r) { ea[r] = __expf(eav[r]); rsum[r] = 0.f; }
#pragma unroll
                for (int pt = 0; pt < 4; ++pt) { const int p = pt * 16 + l15; const u32x2 xw = *(const u32x2*)(XT + p * 72 + lc);
                    const float xv[4] = {bf_lo(xw.x), bf_hi(xw.x), bf_lo(xw.y), bf_hi(xw.y)}; const float nwp = nw[h * 64 + p];
#pragma unroll
                    for (int r = 0; r < 4; ++r) { const int t = t0 + lc + r; float y = yd[pt][r] + ea[r] * yo[pt][r] + Dh * xv[r];
                        const float z = bf2f(U[(size_t)t * UP + 4608 + h * 64 + p]); y *= z / (1.0f + __expf(-z)); rsum[r] += y * y;
                        YC[(size_t)t * 2048 + 1024 + h * 64 + p] = f2bf(y * nwp); } }
#pragma unroll
                for (int r = 0; r < 4; ++r) { float v = rsum[r]; v += __shfl_xor(v, 1); v += __shfl_xor(v, 2); v += __shfl_xor(v, 4); v += __shfl_xor(v, 8); if (l15 == 0) unsafeAtomicAdd(RSS + t0 + lc + r, v); }
            }
            __syncthreads();
        }
        if (PH(12)) for (int it = bid; it < 256; it += G) { const int h = it >> 4, s = it & 15;
            fox_unit(lds, U, Vt, CL, YC, h, 31 - s);
            fox_unit(lds, U, Vt, CL, YC, h, s); }
    }
    grid.sync();

    if (PH(5)) { TVARS for (int i = gtid; i < SEQ * 128; i += nthr) { const int row = i >> 7, ck = i & 127; const float rs = 1.0f / sqrtf(RSS[row] * (1.0f / 1024.0f) + 1e-6f);
        bf16_t* p = YC + (size_t)row * 2048 + 1024 + ck * 8; const u32x4 v = *(const u32x4*)p;
        u32x4 o; o.x = pk_bf16(bf_lo(v.x) * rs, bf_hi(v.x) * rs); o.y = pk_bf16(bf_lo(v.y) * rs, bf_hi(v.y) * rs); o.z = pk_bf16(bf_lo(v.z) * rs, bf_hi(v.z) * rs); o.w = pk_bf16(bf_lo(v.w) * rs, bf_hi(v.w) * rs);
        *(u32x4*)p = o; } }
    grid.sync();

    if (PH(6)) {
        pg8::Gemm g{YC, Wout_t, SEQ, DM, DM, DM}; pg8::StaticOrder S; S.init(SEQ, DM, G, bid);
        pg8::EpiRes<0> E{x, out, XW, P.in[12], RS1, nullptr, nullptr};
        pg8::gemm_phase<pg8::EpiRes<0>, pg8::StaticOrder, true, true>(glds, g, S, E);
    }
    grid.sync();

    if (PH(7)) {
        pg8::Gemm g{XW, Wgu_t, SEQ, GUP, DM, DM}; pg8::StaticOrder S; S.init(SEQ, GUP, G, bid);
        pg8::EpiRowScaleBf16 E{GU, GUP, RS1};
        pg8::gemm_phase<pg8::EpiRowScaleBf16, pg8::StaticOrder, true, true>(glds, g, S, E);
    }
    grid.sync();

    if (PH(8)) { TVARS
        const float* fw = P.in[14]; const float* fb = P.in[15];
        for (int it = gtid; it < 704 * 256; it += nthr) {
            const int ck = it % 704, seg = it / 704, tb = seg * 32, col = ck * 8;
            f32x4 w0a = *(const f32x4*)(fw + col), w0b = *(const f32x4*)(fw + col + 4), w1a = *(const f32x4*)(fw + DFF + col), w1b = *(const f32x4*)(fw + DFF + col + 4);
            f32x4 w2a = *(const f32x4*)(fw + 2 * DFF + col), w2b = *(const f32x4*)(fw + 2 * DFF + col + 4), ba = *(const f32x4*)(fb + col), bb = *(const f32x4*)(fb + col + 4);
            u32x4 gm2 = {0u, 0u, 0u, 0u}, gm1 = {0u, 0u, 0u, 0u};
            if (tb > 0) { gm2 = *(const u32x4*)(GU + (size_t)(tb - 2) * GUP + col); gm1 = *(const u32x4*)(GU + (size_t)(tb - 1) * GUP + col); }
            for (int t = tb; t < tb + 32; ++t) {
                const u32x4 g0 = *(const u32x4*)(GU + (size_t)t * GUP + col); const u32x4 uu = *(const u32x4*)(GU + (size_t)t * GUP + DFF + col);
                f32x4 va, vb;
                va[0] = ba[0] + w0a[0] * bf_lo(gm2.x) + w1a[0] * bf_lo(gm1.x) + w2a[0] * bf_lo(g0.x); va[1] = ba[1] + w0a[1] * bf_hi(gm2.x) + w1a[1] * bf_hi(gm1.x) + w2a[1] * bf_hi(g0.x);
                va[2] = ba[2] + w0a[2] * bf_lo(gm2.y) + w1a[2] * bf_lo(gm1.y) + w2a[2] * bf_lo(g0.y); va[3] = ba[3] + w0a[3] * bf_hi(gm2.y) + w1a[3] * bf_hi(gm1.y) + w2a[3] * bf_hi(g0.y);
                vb[0] = bb[0] + w0b[0] * bf_lo(gm2.z) + w1b[0] * bf_lo(gm1.z) + w2b[0] * bf_lo(g0.z); vb[1] = bb[1] + w0b[1] * bf_hi(gm2.z) + w1b[1] * bf_hi(gm1.z) + w2b[1] * bf_hi(g0.z);
                vb[2] = bb[2] + w0b[2] * bf_lo(gm2.w) + w1b[2] * bf_lo(gm1.w) + w2b[2] * bf_lo(g0.w); vb[3] = bb[3] + w0b[3] * bf_hi(gm2.w) + w1b[3] * bf_hi(gm1.w) + w2b[3] * bf_hi(g0.w);
                const f32x4 ua = {bf_lo(uu.x), bf_hi(uu.x), bf_lo(uu.y), bf_hi(uu.y)}, ub = {bf_lo(uu.z), bf_hi(uu.z), bf_lo(uu.w), bf_hi(uu.w)};
#pragma unroll
                for (int i = 0; i < 4; ++i) { va[i] = va[i] / (1.0f + __expf(-va[i])) * ua[i]; vb[i] = vb[i] / (1.0f + __expf(-vb[i])) * ub[i]; }
                *(u32x4*)(GU + (size_t)t * GUP + DFF + col) = pk8(va, vb);
                gm2 = gm1; gm1 = g0;
            }
        }
    }
    grid.sync();

    if (PH(9)) {
        pg8::Gemm g{GU + DFF, Wd_t, SEQ, DM, DFF, GUP}; pg8::StaticOrder S; S.init(SEQ, DM, G, bid);
        pg8::EpiRes<1> E{out, out, XW, P.in[17], RS2, nullptr, nullptr};
        pg8::gemm_phase<pg8::EpiRes<1>, pg8::StaticOrder, true, true>(glds, g, S, E);
    }
    grid.sync();

    if (PH(10)) {
        pg8::Gemm g{XW, Wpg_t, SEQ, DM, DM, DM}; pg8::StaticOrder S; S.init(SEQ, DM, G, bid);
        pg8::EpiRes<2> E{out, out, nullptr, nullptr, RS3, RS2, PP};
        pg8::gemm_phase<pg8::EpiRes<2>, pg8::StaticOrder, true, true>(glds, g, S, E);
    }
    grid.sync();

    if (PH(11)) { TVARS
        const float* fnw = P.in[20];
        for (int i = gtid; i < SEQ * 512; i += nthr) { const int row = i >> 9, c4 = i & 511; const float rs = 1.0f / sqrtf(RS3[row] * (1.0f / 2048.0f) + 1e-6f);
            f32x4* p = (f32x4*)(out + (size_t)row * DM) + c4; const f32x4 w = ((const f32x4*)fnw)[c4]; *p = (*p) * rs * w; }
    }
}

extern "C" void kernel_launch(void* const* d_in, const int* in_sizes, int n_in, void* d_out, int out_size, void* d_ws, size_t ws_size, hipStream_t stream) {
    static int grid = 0;
    if (grid == 0) {
        if (n_in != 21 || out_size != SEQ * DM || ws_size < WS_END) { fprintf(stderr, "kernel_launch: unexpected problem (n_in %d, out %d, ws %zu)\n", n_in, out_size, ws_size); grid = -1; return; }
        int dev = 0, cus = 0, per_cu = 0;
        hipGetDevice(&dev); hipDeviceGetAttribute(&cus, hipDeviceAttributeMultiprocessorCount, dev);
        hipFuncSetAttribute((const void*)fwd_megakernel, hipFuncAttributeMaxDynamicSharedMemorySize, LDS_BYTES);
        hipOccupancyMaxActiveBlocksPerMultiprocessor(&per_cu, (const void*)fwd_megakernel, NTHREADS, LDS_BYTES);
        if (per_cu < 1) { fprintf(stderr, "kernel_launch: occupancy query says %d blocks per CU\n", per_cu); per_cu = 1; }
        (void)hipGetLastError();
        grid = cus;
    }
    if (grid < 0) return;
    Params p{};
    for (int i = 0; i < 21; ++i) p.in[i] = (const float*)d_in[i];
    p.out = (float*)d_out; p.ws = (unsigned char*)d_ws;
    void* args[] = {&p};
    hipError_t e = hipLaunchCooperativeKernel((const void*)fwd_megakernel, dim3(grid), dim3(NTHREADS), args, LDS_BYTES, stream);
    if (e != hipSuccess) fprintf(stderr, "cooperative launch failed: %s (grid %d)\n", hipGetErrorString(e), grid);
}
```

```cpp
#include <hip/hip_runtime.h>
#include <hip/hip_cooperative_groups.h>
#include <cstdio>
#include <cstdint>
namespace cg = cooperative_groups;
namespace pg8 {
#define PG8_LAS __attribute__((address_space(3)))
typedef unsigned short bf16_t;
typedef short bf16x8 __attribute__((ext_vector_type(8)));
typedef float f32x4 __attribute__((ext_vector_type(4)));
typedef unsigned u32x4 __attribute__((ext_vector_type(4)));
constexpr int BM = 256, BK = 64, HALF = 128, HTB = HALF * BK * 2  , STAGE_BYTES = 8 * HTB, NXCD = 8, WGM = 8;

__host__ __device__ __forceinline__ int lds_byte(int r, int c) { const int st = (r >> 4) * 2 + (c >> 5), rr = r & 15, cc = c & 31, ob = rr * 64 + cc * 2; return st * 1024 + (ob ^ (((ob >> 9) & 1) << 5)); }
__host__ __device__ __forceinline__ void stage_rc(int b, int& R, int& C) { const int st = b / 1024, sb = b % 1024, swz = sb ^ (((sb >> 9) & 1) << 5); R = (st >> 1) * 16 + swz / 64; C = (st & 1) * 32 + (swz % 64) / 2; }
__host__ __device__ __forceinline__ int perm32(int rho) { const int n = rho >> 4, i = rho & 15; return 8 * (i >> 2) + 4 * n + (i & 3); }

struct Unit { int pm, pn; };
struct Gemm { const bf16_t* A; const bf16_t* Bt; int M, N, K, lda; };

struct StaticOrder {
    int nM, nN, nwg, G, c;
    __host__ __device__ void init(int M, int N, int G_, int c_) { nM = M / BM; nN = N / BM; nwg = nM * nN; G = G_; c = c_; }
    __host__ __device__ bool next(int i, Unit& u) const {
        const long L = (long)i * G + c; if (L >= nwg) return false;
        int wgid = (int)L; { const int q = nwg / NXCD, r = nwg % NXCD, xcd = wgid % NXCD, off = wgid / NXCD; wgid = (xcd < r ? xcd * (q + 1) : r * (q + 1) + (xcd - r) * q) + off; }
        const int nig = WGM * nN, gid = wgid / nig, fm = gid * WGM, gsz = (nM - fm) < WGM ? (nM - fm) : WGM;
        u.pm = fm + ((wgid % nig) % gsz); u.pn = (wgid % nig) / gsz; return true;
    }
    __device__ __forceinline__ void a_ready(const Unit&) const {}
    __device__ __forceinline__ void done(const Unit&) const {}
};

__device__ __forceinline__ unsigned cvt_pk_bf16(float lo, float hi) { unsigned r; asm volatile("v_cvt_pk_bf16_f32 %0, %1, %2" : "=v"(r) : "v"(lo), "v"(hi)); return r; }
typedef float f32x2 __attribute__((ext_vector_type(2)));
__device__ __forceinline__ f32x2 gelu_pk(f32x2 v) {
    const f32x2 av = __builtin_elementwise_abs(v), d = av * 0.2316418882f + 1.0f;
    f32x2 t; t.x = __builtin_amdgcn_rcpf(d.x); t.y = __builtin_amdgcn_rcpf(d.y);
    f32x2 q = t * 0.5307027145f + (-0.7265760135f); q = q * t + 0.7107068705f; q = q * t + (-0.142248368f); q = q * t + 0.127414796f; q = q * t;
    const f32x2 s = (v * v) * (-0.72134752044f);
    f32x2 e; e.x = __builtin_amdgcn_exp2f(s.x); e.y = __builtin_amdgcn_exp2f(s.y);
    const f32x2 m = v * (q * e), r = v - m;
    f32x2 o; o.x = v.x < 0.f ? m.x : r.x; o.y = v.y < 0.f ? m.y : r.y; return o;
}

template <int ACT  > struct EpiBf16 {
    static constexpr bool PERM = true, AFTER_DRAIN = false; static_assert(ACT == 0 || ACT == 1, "EpiBf16: ACT is 0 (none) or 1 (gelu_pk)");
    bf16_t* O; int ldc; const float* bias; int split_cols; size_t split_stride; float scale0;
    __device__ __forceinline__ void operator()(const f32x4 (&acc)[2][2][4][2], const Unit& u, int wr, int wc, int fr, int fq) const {
        const int row0 = u.pm * BM + wr * 64 + fr; int colt = u.pn * BM; bf16_t* base = O;
        float sc = 1.f; if (split_cols) { const int t = colt / split_cols; base += (size_t)t * split_stride; colt -= t * split_cols; if (t == 0) sc = scale0; }
        const int col0 = colt + wc * 32 + 8 * fq, bcol0 = u.pn * BM + wc * 32 + 8 * fq;
        f32x4 bv[2][2];
#pragma unroll
        for (int bj = 0; bj < 2; ++bj)
#pragma unroll
            for (int n = 0; n < 2; ++n) bv[bj][n] = bias ? *(const f32x4*)(bias + bcol0 + bj * HALF + 4 * n) : (f32x4){0.f, 0.f, 0.f, 0.f};
#pragma unroll
        for (int ai = 0; ai < 2; ++ai)
#pragma unroll
            for (int m = 0; m < 4; ++m) { bf16_t* rowp = base + (size_t)(row0 + ai * HALF + m * 16) * ldc + col0;
#pragma unroll
                for (int bj = 0; bj < 2; ++bj) { f32x4 v0 = acc[ai][bj][m][0] + bv[bj][0], v1 = acc[ai][bj][m][1] + bv[bj][1];
                    if (ACT == 1) { f32x2 a = gelu_pk((f32x2){v0[0], v0[1]}), b = gelu_pk((f32x2){v0[2], v0[3]}), c = gelu_pk((f32x2){v1[0], v1[1]}), d = gelu_pk((f32x2){v1[2], v1[3]});
                        v0 = (f32x4){a.x, a.y, b.x, b.y}; v1 = (f32x4){c.x, c.y, d.x, d.y}; }
                    v0 = v0 * sc; v1 = v1 * sc; u32x4 w; w.x = cvt_pk_bf16(v0[0], v0[1]); w.y = cvt_pk_bf16(v0[2], v0[3]); w.z = cvt_pk_bf16(v1[0], v1[1]); w.w = cvt_pk_bf16(v1[2], v1[3]);
                    *(u32x4*)(rowp + bj * HALF) = w; } }
    }
};
template <class Epi, class Sched, bool ALIGN_EPI = false, bool SP2 = false>
__device__ __forceinline__ void gemm_phase(PG8_LAS unsigned char* lds, const Gemm g, const Sched& S, const Epi& E) {
    const int tid = threadIdx.x, wid = __builtin_amdgcn_readfirstlane(tid >> 6), lane = tid & 63, wr = wid >> 2, wc = wid & 3, fr = lane & 15, fq = lane >> 4;
    const int K = g.K, nt = K / BK;
    unsigned voffA[2], voffB[2];
#pragma unroll
    for (int i = 0; i < 2; ++i) { int R, C; stage_rc(tid * 16 + i * 8192, R, C); const int Rb = Epi::PERM ? ((R & ~31) + perm32(R & 31)) : R;
        voffA[i] = (unsigned)(R * g.lda + C) * 2u; voffB[i] = (unsigned)(Rb * K + C) * 2u; }
    const size_t kstep = (size_t)(BK * 2);
    const size_t hstepA = (size_t)HALF * g.lda * 2, hstepB = (size_t)HALF * K * 2;
    const size_t tstepA = 2 * hstepA, tstepB = 2 * hstepB;
    const unsigned ldsw = (unsigned)wid * 1024u;
    const int aoff = lds_byte(wr * 64 + fr, fq * 8), boff = lds_byte(wc * 32 + fr, fq * 8);
#define PG8_SA(b, h) (((b) * 2 + (h)) * HTB)
#define PG8_SB(b, h) ((4 + (b) * 2 + (h)) * HTB)
#define PG8_STAGE(bufoff, gbase, voff) do { _Pragma("unroll") for (int _i = 0; _i < 2; ++_i) \
        __builtin_amdgcn_global_load_lds((const unsigned*)((const char*)(gbase) + (voff)[_i]), (PG8_LAS unsigned*)(lds + (bufoff) + ldsw + _i * 8192), 16, 0, 0); } while (0)
#define PG8_LDA(dst, b, h) do { _Pragma("unroll") for (int m = 0; m < 4; ++m) _Pragma("unroll") for (int k = 0; k < 2; ++k) dst[m][k] = *(const PG8_LAS bf16x8*)(lds + PG8_SA(b, h) + aoff + m * 2048 + k * 1024); } while (0)
#define PG8_LDB(dst, b, h) do { _Pragma("unroll") for (int n = 0; n < 2; ++n) _Pragma("unroll") for (int k = 0; k < 2; ++k) dst[n][k] = *(const PG8_LAS bf16x8*)(lds + PG8_SB(b, h) + boff + n * 2048 + k * 1024); } while (0)
#define PG8_MMA(ai, bj, At, Bt) do { __builtin_amdgcn_s_setprio(1); _Pragma("unroll") for (int m = 0; m < 4; ++m) _Pragma("unroll") for (int n = 0; n < 2; ++n) _Pragma("unroll") for (int k = 0; k < 2; ++k) \
        acc[ai][bj][m][n] = __builtin_amdgcn_mfma_f32_16x16x32_bf16(Bt[n][k], At[m][k], acc[ai][bj][m][n], 0, 0, 0); __builtin_amdgcn_s_setprio(0); } while (0)
#define PG8_WAIT_V(n) asm volatile("s_waitcnt vmcnt(" #n ")" ::: "memory")
#define PG8_WAIT_L(n) asm volatile("s_waitcnt lgkmcnt(" #n ")" ::: "memory")
#define PG8_BAR __builtin_amdgcn_s_barrier()
#define PG8_SCHED __builtin_amdgcn_sched_barrier(0)
    Unit cur, nxt; int ui = 0;
    if (!S.next(0, cur)) return;
    f32x4 acc[2][2][4][2];
#pragma unroll
    for (int a = 0; a < 2; ++a)
#pragma unroll
        for (int b = 0; b < 2; ++b)
#pragma unroll
            for (int m = 0; m < 4; ++m)
#pragma unroll
                for (int n = 0; n < 2; ++n) acc[a][b][m][n] = (f32x4){0.f, 0.f, 0.f, 0.f};
    bf16x8 At[4][2], B0[2][2], B1[2][2];
    const char* cA = (const char*)g.A + (size_t)cur.pm * tstepA; const char* cB = (const char*)g.Bt + (size_t)cur.pn * tstepB;
    S.a_ready(cur);
    if constexpr (SP2) {
        PG8_STAGE(PG8_SB(0, 0), cB, voffB); PG8_STAGE(PG8_SB(0, 1), cB + hstepB, voffB); PG8_STAGE(PG8_SA(0, 0), cA, voffA); PG8_STAGE(PG8_SA(0, 1), cA + hstepA, voffA);
        if (wr == 1) PG8_BAR;
        PG8_WAIT_V(2); PG8_BAR;
        PG8_STAGE(PG8_SB(1, 0), cB + kstep, voffB); PG8_STAGE(PG8_SA(1, 0), cA + kstep, voffA); PG8_STAGE(PG8_SB(1, 1), cB + hstepB + kstep, voffB);
        PG8_WAIT_V(6); PG8_BAR;
    } else {
        PG8_STAGE(PG8_SB(0, 0), cB, voffB); PG8_STAGE(PG8_SA(0, 0), cA, voffA); PG8_STAGE(PG8_SB(0, 1), cB + hstepB, voffB); PG8_STAGE(PG8_SA(0, 1), cA + hstepA, voffA);
        if (wr == 1) PG8_BAR;
        PG8_WAIT_V(4); PG8_BAR;
        PG8_STAGE(PG8_SB(1, 0), cB + kstep, voffB); PG8_STAGE(PG8_SA(1, 0), cA + kstep, voffA); PG8_STAGE(PG8_SB(1, 1), cB + hstepB + kstep, voffB);
        PG8_WAIT_V(6); PG8_BAR;
    }
    for (;;) {
        const bool has_next = S.next(ui + 1, nxt);
        const char* nA = has_next ? (const char*)g.A + (size_t)nxt.pm * tstepA : cA; const char* nB = has_next ? (const char*)g.Bt + (size_t)nxt.pn * tstepB : cB;
        for (int t = 0; t < nt; t += 2) {
            const bool last = (t == nt - 2);
            const char* a1 = cA + (size_t)(t + 1) * kstep;
            const char* a2 = last ? nA : cA + (size_t)(t + 2) * kstep; const char* b2 = last ? nB : cB + (size_t)(t + 2) * kstep;
            const char* a3 = a2 + kstep; const char* b3 = b2 + kstep;
            if (last && has_next) S.a_ready(nxt);
            if constexpr (SP2) {
            PG8_LDB(B0, 0, 0); PG8_LDB(B1, 0, 1); PG8_SCHED; PG8_LDA(At, 0, 0); PG8_STAGE(PG8_SA(1, 1), a1 + hstepA, voffA);
            PG8_WAIT_V(8); PG8_WAIT_L(0); PG8_BAR; PG8_MMA(0, 0, At, B0); PG8_MMA(0, 1, At, B1); PG8_BAR; PG8_SCHED;
            PG8_LDA(At, 0, 1); PG8_STAGE(PG8_SB(0, 0), b2, voffB); PG8_STAGE(PG8_SB(0, 1), b2 + hstepB, voffB); PG8_STAGE(PG8_SA(0, 0), a2, voffA);
            PG8_WAIT_V(8); PG8_WAIT_L(0); PG8_BAR; PG8_MMA(1, 0, At, B0); PG8_MMA(1, 1, At, B1); PG8_BAR; PG8_SCHED;
            PG8_LDB(B0, 1, 0); PG8_LDB(B1, 1, 1); PG8_SCHED; PG8_LDA(At, 1, 0); PG8_STAGE(PG8_SA(0, 1), a2 + hstepA, voffA);
            PG8_WAIT_V(8); PG8_WAIT_L(0); PG8_BAR; PG8_MMA(0, 0, At, B0); PG8_MMA(0, 1, At, B1); PG8_BAR; PG8_SCHED;
            PG8_LDA(At, 1, 1); PG8_STAGE(PG8_SB(1, 0), b3, voffB); PG8_STAGE(PG8_SB(1, 1), b3 + hstepB, voffB); PG8_STAGE(PG8_SA(1, 0), a3, voffA);
            PG8_WAIT_V(8); PG8_WAIT_L(0); PG8_BAR; PG8_MMA(1, 0, At, B0); PG8_MMA(1, 1, At, B1); PG8_BAR; PG8_SCHED;
            } else {
            PG8_LDB(B0, 0, 0); PG8_SCHED; PG8_LDA(At, 0, 0); PG8_STAGE(PG8_SA(1, 1), a1 + hstepA, voffA);
            PG8_WAIT_L(8); PG8_BAR; PG8_WAIT_L(0); PG8_MMA(0, 0, At, B0); PG8_BAR; PG8_SCHED;
            PG8_LDB(B1, 0, 1); PG8_STAGE(PG8_SB(0, 0), b2, voffB);
            PG8_BAR; PG8_WAIT_L(0); PG8_MMA(0, 1, At, B1); PG8_BAR;
            PG8_LDA(At, 0, 1); PG8_STAGE(PG8_SA(0, 0), a2, voffA);
            PG8_BAR; PG8_WAIT_L(0); PG8_MMA(1, 0, At, B0); PG8_BAR; PG8_SCHED;
            PG8_STAGE(PG8_SB(0, 1), b2 + hstepB, voffB);
            PG8_WAIT_V(6); PG8_BAR; PG8_MMA(1, 1, At, B1); PG8_BAR;
            PG8_LDB(B0, 1, 0); PG8_SCHED; PG8_LDA(At, 1, 0); PG8_STAGE(PG8_SA(0, 1), a2 + hstepA, voffA);
            PG8_WAIT_L(8); PG8_BAR; PG8_WAIT_L(0); PG8_MMA(0, 0, At, B0); PG8_BAR; PG8_SCHED;
            PG8_LDB(B1, 1, 1); PG8_STAGE(PG8_SB(1, 0), b3, voffB);
            PG8_BAR; PG8_WAIT_L(0); PG8_MMA(0, 1, At, B1); PG8_BAR;
            PG8_LDA(At, 1, 1); PG8_STAGE(PG8_SA(1, 0), a3, voffA);
            PG8_BAR; PG8_WAIT_L(0); PG8_MMA(1, 0, At, B0); PG8_BAR; PG8_SCHED;
            PG8_STAGE(PG8_SB(1, 1), b3 + hstepB, voffB);
            PG8_WAIT_V(6); PG8_BAR; PG8_MMA(1, 1, At, B1); PG8_BAR;
            }
        }
        if constexpr (ALIGN_EPI) { if (wr == 0) PG8_BAR; }
        if constexpr (!Epi::AFTER_DRAIN) { E(acc, cur, wr, wc, fr, fq); S.done(cur); }
        if (!has_next) break;
#pragma unroll
        for (int a = 0; a < 2; ++a)
#pragma unroll
            for (int b = 0; b < 2; ++b)
#pragma unroll
                for (int m = 0; m < 4; ++m)
#pragma unroll
                    for (int n = 0; n < 2; ++n) acc[a][b][m][n] = (f32x4){0.f, 0.f, 0.f, 0.f};
        cur = nxt; cA = nA; cB = nB; ++ui;
        if constexpr (ALIGN_EPI) { if (wr == 1) PG8_BAR; }
    }
    PG8_WAIT_V(0);
    if constexpr (!ALIGN_EPI) { if (wr == 0) PG8_BAR; }
    PG8_BAR;
    if constexpr (Epi::AFTER_DRAIN) { E.fused(acc, cur, wr, wc, fr, fq, lds, wid, lane); S.done(cur); }
#undef PG8_SA
#undef PG8_SB
#undef PG8_STAGE
#undef PG8_LDA
#undef PG8_LDB
#undef PG8_MMA
#undef PG8_WAIT_V
#undef PG8_WAIT_L
#undef PG8_BAR
#undef PG8_SCHED
}
}

namespace pg8 {
typedef unsigned u32x2v __attribute__((ext_vector_type(2)));
__device__ __forceinline__ unsigned pk_bf16(float lo, float hi) { typedef float f2 __attribute__((ext_vector_type(2))); typedef __bf16 b2 __attribute__((ext_vector_type(2))); f2 v = {lo, hi}; b2 b = __builtin_convertvector(v, b2); return __builtin_bit_cast(unsigned, b); }
__device__ __forceinline__ float bf_lo(unsigned w) { return __uint_as_float(w << 16); }
__device__ __forceinline__ float bf_hi(unsigned w) { return __uint_as_float(w & 0xffff0000u); }
__device__ __forceinline__ u32x4 pk8(f32x4 a, f32x4 b) { u32x4 w; w.x = pk_bf16(a[0], a[1]); w.y = pk_bf16(a[2], a[3]); w.z = pk_bf16(b[0], b[1]); w.w = pk_bf16(b[2], b[3]); return w; }

struct EpiInProj {
    static constexpr bool PERM = true, AFTER_DRAIN = false;
    bf16_t* U; float* AUX; float qscale;
    __device__ __forceinline__ void operator()(const f32x4 (&acc)[2][2][4][2], const Unit& u, int wr, int wc, int fr, int fq) const {
        const int row0 = u.pm * BM + wr * 64 + fr;
        if (u.pn < 22) {
            const float sc = (u.pn < 4) ? qscale : 1.f;
            const int col0 = u.pn * BM + wc * 32 + 8 * fq;
#pragma unroll
            for (int ai = 0; ai < 2; ++ai)
#pragma unroll
                for (int m = 0; m < 4; ++m) { bf16_t* rowp = U + (size_t)(row0 + ai * HALF + m * 16) * 5632 + col0;
#pragma unroll
                    for (int bj = 0; bj < 2; ++bj) *(u32x4*)(rowp + bj * HALF) = pk8(acc[ai][bj][m][0] * sc, acc[ai][bj][m][1] * sc); }
        } else if (wc == 0) {
#pragma unroll
            for (int ai = 0; ai < 2; ++ai)
#pragma unroll
                for (int m = 0; m < 4; ++m) { float* rp = AUX + (size_t)(row0 + ai * HALF + m * 16) * 32 + 8 * fq;
                    *(f32x4*)rp = acc[ai][0][m][0]; *(f32x4*)(rp + 4) = acc[ai][0][m][1]; }
        }
    }
};
struct EpiPlainBf16 {
    static constexpr bool PERM = true, AFTER_DRAIN = false;
    bf16_t* O; int ldc;
    __device__ __forceinline__ void operator()(const f32x4 (&acc)[2][2][4][2], const Unit& u, int wr, int wc, int fr, int fq) const {
        const int row0 = u.pm * BM + wr * 64 + fr; const int col0 = u.pn * BM + wc * 32 + 8 * fq;
#pragma unroll
        for (int ai = 0; ai < 2; ++ai)
#pragma unroll
            for (int m = 0; m < 4; ++m) { bf16_t* rowp = O + (size_t)(row0 + ai * HALF + m * 16) * ldc + col0;
#pragma unroll
                for (int bj = 0; bj < 2; ++bj) *(u32x4*)(rowp + bj * HALF) = pk8(acc[ai][bj][m][0], acc[ai][bj][m][1]); }
    }
};
struct EpiRowScaleBf16 {
    static constexpr bool PERM = true, AFTER_DRAIN = false;
    bf16_t* O; int ldc; const float* rowsq;
    __device__ __forceinline__ void operator()(const f32x4 (&acc)[2][2][4][2], const Unit& u, int wr, int wc, int fr, int fq) const {
        const int row0 = u.pm * BM + wr * 64 + fr; const int col0 = u.pn * BM + wc * 32 + 8 * fq;
#pragma unroll
        for (int ai = 0; ai < 2; ++ai)
#pragma unroll
            for (int m = 0; m < 4; ++m) { const int row = row0 + ai * HALF + m * 16; const float rs = 1.0f / sqrtf(rowsq[row] * (1.0f / 2048.0f) + 1e-6f);
                bf16_t* rowp = O + (size_t)row * ldc + col0;
#pragma unroll
                for (int bj = 0; bj < 2; ++bj) *(u32x4*)(rowp + bj * HALF) = pk8(acc[ai][bj][m][0] * rs, acc[ai][bj][m][1] * rs); }
    }
};
template <int MODE> struct EpiRes {
    static constexpr bool PERM = true, AFTER_DRAIN = false;
    const float* base; float* out; bf16_t* XW; const float* nw; float* rowsq_out; const float* rowsq_in; const bf16_t* PP;
    __device__ __forceinline__ void operator()(const f32x4 (&acc)[2][2][4][2], const Unit& u, int wr, int wc, int fr, int fq) const {
        const int row0 = u.pm * BM + wr * 64 + fr; const int col0 = u.pn * BM + wc * 32 + 8 * fq;
        f32x4 nwv[2][2];
#pragma unroll
        for (int bj = 0; bj < 2; ++bj)
#pragma unroll
            for (int n = 0; n < 2; ++n) nwv[bj][n] = (MODE != 2) ? *(const f32x4*)(nw + col0 + bj * HALF + 4 * n) : (f32x4){0.f, 0.f, 0.f, 0.f};
#pragma unroll
        for (int ai = 0; ai < 2; ++ai)
#pragma unroll
            for (int m = 0; m < 4; ++m) {
                const int row = row0 + ai * HALF + m * 16; const size_t off = (size_t)row * 2048 + col0;
                float rs = 0.f; if (MODE == 2) rs = 1.0f / sqrtf(rowsq_in[row] * (1.0f / 2048.0f) + 1e-6f);
                float ss = 0.f;
#pragma unroll
                for (int bj = 0; bj < 2; ++bj) {
                    const f32x4 b0 = *(const f32x4*)(base + off + bj * HALF), b1 = *(const f32x4*)(base + off + bj * HALF + 4);
                    f32x4 a0 = acc[ai][bj][m][0], a1 = acc[ai][bj][m][1];
                    if (MODE == 2) {
                        const u32x4 pw = *(const u32x4*)(PP + off + bj * HALF);
                        const f32x4 p0 = {bf_lo(pw.x), bf_hi(pw.x), bf_lo(pw.y), bf_hi(pw.y)}, p1 = {bf_lo(pw.z), bf_hi(pw.z), bf_lo(pw.w), bf_hi(pw.w)};
#pragma unroll
                        for (int i = 0; i < 4; ++i) { a0[i] = p0[i] / (1.0f + __expf(-rs * a0[i])); a1[i] = p1[i] / (1.0f + __expf(-rs * a1[i])); }
                    }
                    const f32x4 x0 = b0 + a0, x1 = b1 + a1;
                    *(f32x4*)(out + off + bj * HALF) = x0; *(f32x4*)(out + off + bj * HALF + 4) = x1;
                    ss += (x0[0] * x0[0] + x0[1] * x0[1]) + (x0[2] * x0[2] + x0[3] * x0[3]) + (x1[0] * x1[0] + x1[1] * x1[1]) + (x1[2] * x1[2] + x1[3] * x1[3]);
                    if (MODE != 2) *(u32x4*)(XW + off + bj * HALF) = pk8(x0 * nwv[bj][0], x1 * nwv[bj][1]);
                }
                ss += __shfl_xor(ss, 16); ss += __shfl_xor(ss, 32);
                if (fq == 0) unsafeAtomicAdd(rowsq_out + row, ss);
            }
    }
};
}

using pg8::bf16_t; using pg8::bf16x8; using pg8::f32x4; using pg8::u32x4; using pg8::pk_bf16; using pg8::pk8; using pg8::bf_lo; using pg8::bf_hi;
typedef float f32x16 __attribute__((ext_vector_type(16)));
typedef unsigned u32x2 __attribute__((ext_vector_type(2)));
typedef short s16x4 __attribute__((ext_vector_type(4)));
constexpr int SEQ = 8192, DM = 2048, UP = 5632, NIN = 5888, DFF = 5632, GUP = 11264;
constexpr float LOG2E = 1.4426950408889634f;
constexpr float QSCALE = 0.125f * LOG2E;
constexpr size_t MiB = 1u << 20;
constexpr size_t WS_RS1 = 0, WS_RS2 = 32768, WS_RS3 = 65536, WS_RSS = 98304, WS_CD = 131072, WS_CL = 262144, WS_AUX = 1 * MiB;
constexpr size_t WS_BAR = 2 * MiB, BAR_BYTES = 16384;
constexpr size_t WS_WGU = 4 * MiB, WS_WD = 48 * MiB, WS_WPG = 70 * MiB, WS_WPP = 78 * MiB, WS_XW = 79 * MiB, WS_PP = 111 * MiB;
constexpr size_t WS_WIN = 143 * MiB, WS_WOUT = 166 * MiB, WS_P16 = 174 * MiB, WS_U = 178 * MiB, WS_VT = 266 * MiB, WS_ST = 282 * MiB, WS_YC = 314 * MiB, WS_GU = 143 * MiB;
constexpr size_t WS_END = 346 * MiB;
constexpr int LDS_BYTES = 147456;
constexpr int NTHREADS = 512;

__device__ __forceinline__ float bf2f(bf16_t b) { return __uint_as_float((unsigned)b << 16); }
__device__ __forceinline__ bf16_t f2bf(float f) { return (bf16_t)(pk_bf16(f, 0.f) & 0xffffu); }
__device__ __forceinline__ float s2f(short s) { return __uint_as_float(((unsigned)(unsigned short)s) << 16); }
__device__ __forceinline__ float wave_sum(float v) {
#pragma unroll
    for (int o = 1; o < 64; o <<= 1) v += __shfl_xor(v, o);
    return v;
}
#define LDS_WAIT() asm volatile("s_waitcnt lgkmcnt(0)" ::: "memory")
#define LAS __attribute__((address_space(3)))

__device__ __forceinline__ int inproj_src(int np) { if (np < 3072) return np; if (np < 5632) return np + 16; if (np < 5648) return 3072 + (np - 5632); if (np < 5664) return np; return -1; }

template <bool MAP> __device__ __forceinline__ void transpose_item(const float* __restrict__ W, int K, int N, int ND, bf16_t* WT, float* scr, int item, int lane) {
    const int nblk = ND / 64, kb = item / nblk, nb = item % nblk, k0 = 64 * kb, n0 = 64 * nb;
    const int c4 = (lane & 15) * 4, r4 = lane >> 4;
    int src = n0 + c4; if (MAP) src = inproj_src(src);
    f32x4 v[16];
#pragma unroll
    for (int i = 0; i < 16; ++i) v[i] = (src >= 0) ? *(const f32x4*)(W + (size_t)(k0 + 4 * i + r4) * N + src) : (f32x4){0.f, 0.f, 0.f, 0.f};
#pragma unroll
    for (int i = 0; i < 16; ++i) { float* d = scr + (4 * i + r4) * 65 + c4; d[0] = v[i][0]; d[1] = v[i][1]; d[2] = v[i][2]; d[3] = v[i][3]; }
    LDS_WAIT();
    const int c = lane & 7;
#pragma unroll
    for (int j = 0; j < 8; ++j) { const int n = (lane >> 3) + 8 * j; const float* s = scr + (8 * c) * 65 + n;
        u32x4 o; o.x = pk_bf16(s[0 * 65], s[1 * 65]); o.y = pk_bf16(s[2 * 65], s[3 * 65]); o.z = pk_bf16(s[4 * 65], s[5 * 65]); o.w = pk_bf16(s[6 * 65], s[7 * 65]);
        *(u32x4*)(WT + (size_t)(n0 + n) * K + k0 + 8 * c) = o; }
    LDS_WAIT();
}
__device__ __forceinline__ void rms_row_to_bf16(const float* __restrict__ xrow, const float* __restrict__ w, bf16_t* orow, int lane) {
    const f32x4* xr = (const f32x4*)xrow + lane; const f32x4* wr = (const f32x4*)w + lane;
    f32x4 v[8]; float s = 0.f;
#pragma unroll
    for (int j = 0; j < 8; ++j) { v[j] = xr[64 * j]; s += (v[j].x * v[j].x + v[j].y * v[j].y) + (v[j].z * v[j].z + v[j].w * v[j].w); }
    const float rstd = 1.0f / sqrtf(wave_sum(s) * (1.0f / 2048.0f) + 1e-6f);
    u32x2* o8 = (u32x2*)orow + lane;
#pragma unroll
    for (int j = 0; j < 8; ++j) { const f32x4 wv = wr[64 * j]; u32x2 o; o.x = pk_bf16(v[j].x * rstd * wv.x, v[j].y * rstd * wv.y); o.y = pk_bf16(v[j].z * rstd * wv.z, v[j].w * rstd * wv.w); o8[64 * j] = o; }
}
__device__ __forceinline__ void conv4_silu8(const bf16_t* __restrict__ U, int t, int ch, const float* __restrict__ cw, const float* __restrict__ cb, f32x4& o0, f32x4& o1) {
    f32x4 a0 = *(const f32x4*)(cb + ch), a1 = *(const f32x4*)(cb + ch + 4);
#pragma unroll
    for (int k = 0; k < 4; ++k) { const int tt = t - 3 + k;
        if (tt >= 0) { const u32x4 v = *(const u32x4*)(U + (size_t)tt * UP + 3072 + ch); const f32x4 w0 = *(const f32x4*)(cw + k * 1536 + ch), w1 = *(const f32x4*)(cw + k * 1536 + ch + 4);
            a0[0] += w0[0] * bf_lo(v.x); a0[1] += w0[1] * bf_hi(v.x); a0[2] += w0[2] * bf_lo(v.y); a0[3] += w0[3] * bf_hi(v.y);
            a1[0] += w1[0] * bf_lo(v.z); a1[1] += w1[1] * bf_hi(v.z); a1[2] += w1[2] * bf_lo(v.w); a1[3] += w1[3] * bf_hi(v.w); } }
#pragma unroll
    for (int i = 0; i < 4; ++i) { a0[i] = a0[i] / (1.0f + __expf(-a0[i])); a1[i] = a1[i] / (1.0f + __expf(-a1[i])); }
    o0 = a0; o1 = a1;
}
__device__ __forceinline__ int crow(int r, int hi) { return (r & 3) + 8 * (r >> 2) + 4 * hi; }

constexpr int AT_K = 0, AT_V = 18432, AT_C = 36864;
__device__ __forceinline__ void fox_unit(unsigned char* lds, const bf16_t* __restrict__ U, const bf16_t* __restrict__ Vt, const float* __restrict__ CL, bf16_t* YC, int h, int qb) {
    const int tid = threadIdx.x, lane = tid & 63, r32 = lane & 31, hi = lane >> 5; const int wid = __builtin_amdgcn_readfirstlane(tid >> 6);
    const int q0 = qb * 256, qrow = q0 + wid * 32 + r32, qfirst = q0 + wid * 32;
    bf16x8 qr[4];
#pragma unroll
    for (int d0 = 0; d0 < 4; ++d0) qr[d0] = *(const bf16x8*)(U + (size_t)qrow * UP + h * 64 + d0 * 16 + hi * 8);
    const float cq = CL[h * SEQ + qrow];
    const int NT = 4 * (qb + 1);
    const int lrow = tid >> 3, lck = tid & 7;
    const bf16_t* ksrc = U + (size_t)lrow * UP + 1024 + h * 64 + lck * 8;
    const bf16_t* vsrc = Vt + (size_t)(h * 64 + lrow) * SEQ + lck * 8;
    const float* csrc = CL + h * SEQ + (tid & 15) * 4;
    const int ldoff = (lrow * 72 + lck * 8) * 2;
    u32x4 kreg, vreg; f32x4 creg = {0.f, 0.f, 0.f, 0.f};
    kreg = *(const u32x4*)ksrc; vreg = *(const u32x4*)vsrc; if (tid < 16) creg = *(const f32x4*)csrc;
    *(u32x4*)(lds + AT_K + ldoff) = kreg; *(u32x4*)(lds + AT_V + ldoff) = vreg; if (tid < 16) *(f32x4*)(lds + AT_C + tid * 16) = creg;
    __syncthreads();
    float mrun = -INFINITY, lrun = 0.f;
    f32x16 o0 = {}, o1 = {};
    for (int t = 0; t < NT; ++t) {
        const int cur = t & 1;
        if (t + 1 < NT) { kreg = *(const u32x4*)(ksrc + (size_t)(t + 1) * 64 * UP); vreg = *(const u32x4*)(vsrc + (t + 1) * 64); if (tid < 16) creg = *(const f32x4*)(csrc + (t + 1) * 64); }
        if (64 * t <= qfirst + 31) {
            const unsigned char* Kb = lds + AT_K + cur * 9216; const unsigned char* Vb = lds + AT_V + cur * 9216; const float* Cb = (const float*)(lds + AT_C + cur * 256);
            f32x16 p0, p1;
#pragma unroll
            for (int g = 0; g < 4; ++g) { const f32x4 c0 = *(const f32x4*)(Cb + 8 * g + 4 * hi), c1 = *(const f32x4*)(Cb + 32 + 8 * g + 4 * hi);
#pragma unroll
                for (int i = 0; i < 4; ++i) { p0[4 * g + i] = cq - c0[i]; p1[4 * g + i] = cq - c1[i]; } }
#pragma unroll
            for (int d0 = 0; d0 < 4; ++d0) {
                const bf16x8 a0 = *(const bf16x8*)(Kb + (r32 * 72 + d0 * 16 + hi * 8) * 2);
                const bf16x8 a1 = *(const bf16x8*)(Kb + ((32 + r32) * 72 + d0 * 16 + hi * 8) * 2);
                p0 = __builtin_amdgcn_mfma_f32_32x32x16_bf16(a0, qr[d0], p0, 0, 0, 0);
                p1 = __builtin_amdgcn_mfma_f32_32x32x16_bf16(a1, qr[d0], p1, 0, 0, 0);
            }
            if (64 * t + 63 > qfirst) {
#pragma unroll
                for (int r = 0; r < 16; ++r) { const int kv = 64 * t + crow(r, hi); if (kv > qrow) p0[r] = -INFINITY; if (kv + 32 > qrow) p1[r] = -INFINITY; }
            }
            float rm = fmaxf(p0[0], p1[0]);
#pragma unroll
            for (int r = 1; r < 16; ++r) rm = fmaxf(rm, fmaxf(p0[r], p1[r]));
            rm = fmaxf(rm, __shfl_xor(rm, 32));
            const float mnew = fmaxf(mrun, rm); const float alpha = __builtin_amdgcn_exp2f(mrun - mnew); mrun = mnew;
            float ls = 0.f;
#pragma unroll
            for (int r = 0; r < 16; ++r) { p0[r] = __builtin_amdgcn_exp2f(p0[r] - mnew); p1[r] = __builtin_amdgcn_exp2f(p1[r] - mnew); ls += p0[r] + p1[r]; }
            lrun = lrun * alpha + ls;
#pragma unroll
            for (int r = 0; r < 16; ++r) { o0[r] *= alpha; o1[r] *= alpha; }
#pragma unroll
            for (int b = 0; b < 2; ++b)
#pragma unroll
                for (int s = 0; s < 2; ++s) {
                    u32x4 pw;
                    if (b == 0) { pw.x = pk_bf16(p0[8 * s + 0], p0[8 * s + 1]); pw.y = pk_bf16(p0[8 * s + 2], p0[8 * s + 3]); pw.z = pk_bf16(p0[8 * s + 4], p0[8 * s + 5]); pw.w = pk_bf16(p0[8 * s + 6], p0[8 * s + 7]); }
                    else        { pw.x = pk_bf16(p1[8 * s + 0], p1[8 * s + 1]); pw.y = pk_bf16(p1[8 * s + 2], p1[8 * s + 3]); pw.z = pk_bf16(p1[8 * s + 4], p1[8 * s + 5]); pw.w = pk_bf16(p1[8 * s + 6], p1[8 * s + 7]); }
                    const bf16x8 pb = __builtin_bit_cast(bf16x8, pw);
                    const int kvo = 32 * b + 16 * s + 4 * hi;
                    {   const u32x2 v0 = *(const u32x2*)(Vb + (r32 * 72 + kvo) * 2), v1 = *(const u32x2*)(Vb + (r32 * 72 + kvo + 8) * 2);
                        const u32x4 vv = {v0.x, v0.y, v1.x, v1.y}; o0 = __builtin_amdgcn_mfma_f32_32x32x16_bf16(__builtin_bit_cast(bf16x8, vv), pb, o0, 0, 0, 0); }
                    {   const u32x2 v0 = *(const u32x2*)(Vb + ((32 + r32) * 72 + kvo) * 2), v1 = *(const u32x2*)(Vb + ((32 + r32) * 72 + kvo + 8) * 2);
                        const u32x4 vv = {v0.x, v0.y, v1.x, v1.y}; o1 = __builtin_amdgcn_mfma_f32_32x32x16_bf16(__builtin_bit_cast(bf16x8, vv), pb, o1, 0, 0, 0); }
                }
        }
        if (t + 1 < NT) { const int nb = (cur ^ 1); *(u32x4*)(lds + AT_K + nb * 9216 + ldoff) = kreg; *(u32x4*)(lds + AT_V + nb * 9216 + ldoff) = vreg; if (tid < 16) *(f32x4*)(lds + AT_C + nb * 256 + tid * 16) = creg; }
        __syncthreads();
    }
    lrun += __shfl_xor(lrun, 32);
    const float inv = 1.0f / lrun;
    bf16_t* orow = YC + (size_t)qrow * 2048 + h * 64 + 4 * hi;
#pragma unroll
    for (int g = 0; g < 4; ++g) {
        u32x2 w0, w1;
        w0.x = pk_bf16(o0[4 * g] * inv, o0[4 * g + 1] * inv); w0.y = pk_bf16(o0[4 * g + 2] * inv, o0[4 * g + 3] * inv);
        w1.x = pk_bf16(o1[4 * g] * inv, o1[4 * g + 1] * inv); w1.y = pk_bf16(o1[4 * g + 2] * inv, o1[4 * g + 3] * inv);
        *(u32x2*)(orow + 8 * g) = w0; *(u32x2*)(orow + 32 + 8 * g) = w1;
    }
}
#define XB_TMO      128
#define XB_XCNT(j)  (256  + 64 * (j))
#define XB_XSUB(j)  (1280 + 64 * (j))
#define XB_XGEN(j)  (2304 + 64 * (j))
#define XB_TOP      3328
#define XB_TOPGEN   3392
#define XCD_BAR_WORDS 3456
#define XB_SPIN_CAP (1u << 18)

__device__ __forceinline__ unsigned xb_ld(unsigned* p)              { return __hip_atomic_load(p, __ATOMIC_RELAXED, __HIP_MEMORY_SCOPE_AGENT); }
__device__ __forceinline__ unsigned xb_add(unsigned* p, unsigned v) { return __hip_atomic_fetch_add(p, v, __ATOMIC_RELAXED, __HIP_MEMORY_SCOPE_AGENT); }
__device__ __forceinline__ unsigned xb_xcc_id() { return (unsigned)__builtin_amdgcn_s_getreg((3 << 11) | 20) & 0xFu; }
#define XB_SPIN(cond, bar) do { unsigned _sp = 0; while (cond) { __builtin_amdgcn_s_sleep(1); \
    if ((++_sp & 255u) == 0u) { if (xb_ld(&(bar)[XB_TMO])) break; if (_sp > XB_SPIN_CAP) { atomicAdd(&(bar)[XB_TMO], 1u); break; } } } } while (0)

struct XcdBarrier {
    unsigned* bar; unsigned x;
    volatile LAS unsigned* st;
};

__device__ __forceinline__ XcdBarrier xcd_barrier_post(unsigned* bar, volatile LAS unsigned* st) {
    XcdBarrier b; b.bar = bar; b.x = xb_xcc_id(); b.st = st;
    if (threadIdx.x == 0) (void)xb_add(&bar[XB_XCNT(b.x)], 1u);
    return b;
}
__device__ __forceinline__ void xcd_barrier_complete(unsigned* bar, unsigned x, unsigned& nloc, unsigned& nx) {
    const unsigned G = gridDim.x * gridDim.y * gridDim.z;
    unsigned sum, cnt, mine, sp = 0u;
    for (;;) {
        sum = 0u; cnt = 0u; mine = 0u;
#pragma unroll
        for (unsigned j = 0; j < 16; ++j) { const unsigned c = xb_ld(&bar[XB_XCNT(j)]); sum += c; cnt += (c > 0u) ? 1u : 0u; mine = (j == x) ? c : mine; }
        if (sum == G) break;
        __builtin_amdgcn_s_sleep(1);
        if ((++sp & 255u) == 0u) { if (xb_ld(&bar[XB_TMO])) break; if (sp > XB_SPIN_CAP) { atomicAdd(&bar[XB_TMO], 1u); break; } }
    }
    nloc = mine > 0u ? mine : 1u; nx = cnt > 0u ? cnt : 1u;
}

__device__ __forceinline__ void xcd_barrier(const XcdBarrier& b) {
    asm volatile("s_waitcnt vmcnt(0)" ::: "memory");
    __syncthreads();
    if (threadIdx.x == 0) {
        unsigned* bar = b.bar;
        __builtin_amdgcn_s_waitcnt(0);
        unsigned nloc = b.st[0], nx = b.st[1];
        if (nloc == 0u) { xcd_barrier_complete(bar, b.x, nloc, nx); b.st[0] = nloc; b.st[1] = nx; }
        const unsigned old = xb_add(&bar[XB_XSUB(b.x)], 1u);
        const unsigned gen = old / nloc;
        if (old + 1u == (gen + 1u) * nloc) {
            __builtin_amdgcn_fence(__ATOMIC_RELEASE, "agent");
            asm volatile("s_waitcnt vmcnt(0)" ::: "memory");
            const unsigned og = xb_add(&bar[XB_TOP], 1u);
            const unsigned tg = og / nx;
            if (og + 1u == (tg + 1u) * nx) xb_add(&bar[XB_TOPGEN], 1u);
            else XB_SPIN(xb_ld(&bar[XB_TOPGEN]) == tg, bar);
            __builtin_amdgcn_fence(__ATOMIC_ACQUIRE, "agent");
            xb_add(&bar[XB_XGEN(b.x)], 1u);
            asm volatile("s_waitcnt vmcnt(0)" ::: "memory");
        } else {
            XB_SPIN(xb_ld(&bar[XB_XGEN(b.x)]) == gen, bar);
            __builtin_amdgcn_fence(__ATOMIC_ACQUIRE, "agent");
            asm volatile("s_waitcnt vmcnt(0)" ::: "memory");
        }
    }
    __syncthreads();
}

constexpr int SL_XT = 0;
constexpr int SL_CM = 73728;
constexpr int SL_BM = 91136;
constexpr int SL_GG = 108544;
constexpr int SL_DT = 125952, SL_AC = 128000, SL_SW = 130048;

#ifndef PHMASK
#define PHMASK 0xFFFF
#endif
#define PH(n) ((PHMASK >> (n)) & 1)
struct Params { const float* in[21]; float* out; unsigned char* ws; };

__device__ __forceinline__ void ssd_stage_xt_dt(unsigned char* lds, const bf16_t* U, const float* AUX, const float* cw, const float* cb, float dtb, float Ah, int t0, int h, int wave, int lane, float& dt_out, float& ac_out) {
    bf16_t* XT = (bf16_t*)(lds + SL_XT + wave * 9216);
#pragma unroll 2
    for (int it = 0; it < 8; ++it) { const int idx = it * 64 + lane, s = idx >> 3, ck = idx & 7; f32x4 a0, a1; conv4_silu8(U, t0 + s, h * 64 + ck * 8, cw, cb, a0, a1);
#pragma unroll
        for (int i = 0; i < 4; ++i) { XT[(ck * 8 + i) * 72 + s] = f2bf(a0[i]); XT[(ck * 8 + 4 + i) * 72 + s] = f2bf(a1[i]); } }
    const float xr = AUX[(size_t)(t0 + lane) * 32 + 16 + h] + dtb;
    const float dt = (xr > 20.f) ? xr : log1pf(expf(xr));
    float ac = dt * Ah;
#pragma unroll
    for (int o = 1; o < 64; o <<= 1) { const float n = __shfl_up(ac, o); if (lane >= o) ac += n; }
    dt_out = dt; ac_out = ac;
}

__global__ void __launch_bounds__(NTHREADS, 2) fwd_megakernel(Params P) {
    extern __shared__ __attribute__((aligned(16))) unsigned char lds[];
    cg::grid_group grid = cg::this_grid();
    const int G = gridDim.x, bid = blockIdx.x, nthr = G * NTHREADS;
#define TVARS int tid = threadIdx.x; asm volatile("" : "+v"(tid)); const int lane = tid & 63, wave = __builtin_amdgcn_readfirstlane(tid >> 6), quad = lane >> 4, l15 = lane & 15, gtid = bid * NTHREADS + tid; (void)quad; (void)l15; (void)gtid; (void)wave; (void)lane;
    unsigned char* ws = P.ws;
    const float* x = P.in[0]; float* out = P.out;
    float* RS1 = (float*)(ws + WS_RS1); float* RS2 = (float*)(ws + WS_RS2); float* RS3 = (float*)(ws + WS_RS3); float* RSS = (float*)(ws + WS_RSS);
    float* CD = (float*)(ws + WS_CD); float* CL = (float*)(ws + WS_CL); float* AUX = (float*)(ws + WS_AUX);
    bf16_t* Wgu_t = (bf16_t*)(ws + WS_WGU); bf16_t* Wd_t = (bf16_t*)(ws + WS_WD); bf16_t* Wpg_t = (bf16_t*)(ws + WS_WPG); bf16_t* Wpp_t = (bf16_t*)(ws + WS_WPP);
    bf16_t* XW = (bf16_t*)(ws + WS_XW); bf16_t* PP = (bf16_t*)(ws + WS_PP); bf16_t* Win_t = (bf16_t*)(ws + WS_WIN); bf16_t* Wout_t = (bf16_t*)(ws + WS_WOUT);
    bf16_t* P16 = (bf16_t*)(ws + WS_P16); bf16_t* U = (bf16_t*)(ws + WS_U); bf16_t* Vt = (bf16_t*)(ws + WS_VT); bf16_t* ST = (bf16_t*)(ws + WS_ST);
    bf16_t* YC = (bf16_t*)(ws + WS_YC); bf16_t* GU = (bf16_t*)(ws + WS_GU);
    __attribute__((address_space(3))) unsigned char* glds = (__attribute__((address_space(3))) unsigned char*)lds;
    if (threadIdx.x < 16) ((volatile LAS unsigned*)(glds + LDS_BYTES - 64))[threadIdx.x] = 0u;
    __syncthreads();
    const XcdBarrier xbar = xcd_barrier_post((unsigned*)(ws + WS_BAR), (volatile LAS unsigned*)(glds + LDS_BYTES - 64));
#define GRID_BAR() xcd_barrier(xbar)

#ifndef REP_P0
#define REP_P0 1
#endif
#ifndef REP_P2
#define REP_P2 1
#endif
#ifndef EXTRA_SYNCS
#define EXTRA_SYNCS 0
#endif
    for (int rep0 = 0; rep0 < REP_P0; ++rep0) if (PH(0)) { TVARS
        float* scr = (float*)(lds + wave * 16640);
        const int gw = bid * 8 + wave, NGW = G * 8;
        constexpr int I_IN = 32 * 92, I_OUT = 32 * 32, I_GU = 32 * 176, I_D = 88 * 32, I_PG = 32 * 32, I_PP = 4 * 32;
        constexpr int NITEMS = I_IN + I_OUT + I_GU + I_D + I_PG + I_PP;
        for (int it = gw; it < NITEMS; it += NGW) {
            int r = it;
            if (r < I_IN) { transpose_item<true>(P.in[3], 2048, 5664, NIN, Win_t, scr, r, lane); continue; } r -= I_IN;
            if (r < I_OUT) { transpose_item<false>(P.in[11], 2048, 2048, 2048, Wout_t, scr, r, lane); continue; } r -= I_OUT;
            if (r < I_GU) { transpose_item<false>(P.in[13], 2048, GUP, GUP, Wgu_t, scr, r, lane); continue; } r -= I_GU;
            if (r < I_D) { transpose_item<false>(P.in[16], DFF, 2048, 2048, Wd_t, scr, r, lane); continue; } r -= I_D;
            if (r < I_PG) { transpose_item<false>(P.in[18], 2048, 2048, 2048, Wpg_t, scr, r, lane); continue; } r -= I_PG;
            transpose_item<false>(P.in[19], 256, 2048, 2048, Wpp_t, scr, r, lane);
        }
        for (int m = gw; m < SEQ; m += NGW) rms_row_to_bf16(x + (size_t)m * DM, P.in[2], XW + (size_t)m * DM, lane);
        const float* pin = P.in[1];
        for (int i = gtid; i < SEQ * 256 / 8; i += nthr) { const f32x4 a = *(const f32x4*)(pin + (size_t)i * 8), b = *(const f32x4*)(pin + (size_t)i * 8 + 4); *(u32x4*)(P16 + (size_t)i * 8) = pk8(a, b); }
        for (int i = gtid; i < 4 * SEQ; i += nthr) RS1[i] = 0.f;
    }
    grid.sync();

    if (PH(1)) {
        pg8::Gemm g{XW, Win_t, SEQ, NIN, DM, DM}; pg8::StaticOrder S; S.init(SEQ, NIN, G, bid);
        pg8::EpiInProj E{U, AUX, QSCALE};
        pg8::gemm_phase<pg8::EpiInProj, pg8::StaticOrder, true, true>(glds, g, S, E);
    }
    if (PH(13)) {
        int kpp = 256; asm volatile("" : "+s"(kpp));
        pg8::Gemm g{P16, Wpp_t, SEQ, DM, kpp, kpp}; pg8::StaticOrder S; S.init(SEQ, DM, G, bid);
        pg8::EpiPlainBf16 E{PP, DM};
        pg8::gemm_phase<pg8::EpiPlainBf16, pg8::StaticOrder, true, true>(glds, g, S, E);
    }
    GRID_BAR();

    for (int i = 0; i < EXTRA_SYNCS; ++i) GRID_BAR();
    for (int rep2 = 0; rep2 < REP_P2; ++rep2) {
    if (PH(2)) for (int h = bid; h < 16; h += G) { TVARS
        float* wsum = (float*)(lds + 140000);
        const float bfh = P.in[4][h]; const int t0 = tid * 16;
        float run = 0.f; float loc[16];
#pragma unroll
        for (int i = 0; i < 16; ++i) { const float xv = AUX[(size_t)(t0 + i) * 32 + h] + bfh; const float ls = fminf(xv, 0.f) - log1pf(expf(-fabsf(xv))); run += ls; loc[i] = run; }
        float incl = run;
#pragma unroll
        for (int o = 1; o < 64; o <<= 1) { const float n = __shfl_up(incl, o); if (lane >= o) incl += n; }
        if (lane == 63) wsum[wave] = incl;
        __syncthreads();
        float pre = 0.f;
#pragma unroll
        for (int w = 0; w < 8; ++w) { const float v = wsum[w]; if (w < wave) pre += v; }
        const float excl = pre + incl - run;
#pragma unroll
        for (int i = 0; i < 16; ++i) CL[h * SEQ + t0 + i] = (excl + loc[i]) * LOG2E;
        __syncthreads();
    }
    if (PH(2)) for (int it = bid; it < 2048; it += G) { TVARS
        const int h = it >> 7, tb = it & 127; bf16_t* tileT = (bf16_t*)(lds + 4096);
        const int row = tid >> 3, ck = tid & 7;
        const u32x4 v = *(const u32x4*)(U + (size_t)(tb * 64 + row) * UP + 2048 + h * 64 + ck * 8);
        tileT[(ck * 8 + 0) * 72 + row] = (bf16_t)(v.x & 0xffff); tileT[(ck * 8 + 1) * 72 + row] = (bf16_t)(v.x >> 16);
        tileT[(ck * 8 + 2) * 72 + row] = (bf16_t)(v.y & 0xffff); tileT[(ck * 8 + 3) * 72 + row] = (bf16_t)(v.y >> 16);
        tileT[(ck * 8 + 4) * 72 + row] = (bf16_t)(v.z & 0xffff); tileT[(ck * 8 + 5) * 72 + row] = (bf16_t)(v.z >> 16);
        tileT[(ck * 8 + 6) * 72 + row] = (bf16_t)(v.w & 0xffff); tileT[(ck * 8 + 7) * 72 + row] = (bf16_t)(v.w >> 16);
        __syncthreads();
        const u32x4 o = *(const u32x4*)(tileT + row * 72 + ck * 8);
        *(u32x4*)(Vt + (size_t)(h * 64 + row) * SEQ + tb * 64 + ck * 8) = o;
        __syncthreads();
    }
    if (PH(2)) { TVARS
        const float* cw = P.in[5]; const float* cb = P.in[6];
        for (int it = bid; it < 256; it += G) {
            const int c = it >> 1, g = it & 1, t0 = c * 64, h = g * 8 + wave;
            bf16_t* BMT = (bf16_t*)(lds + SL_CM);
            for (int idx = tid; idx < 1024; idx += NTHREADS) { const int s = idx >> 4, ck = idx & 15; f32x4 a0, a1; conv4_silu8(U, t0 + s, 1024 + g * 128 + ck * 8, cw, cb, a0, a1);
#pragma unroll
                for (int i = 0; i < 4; ++i) { BMT[(ck * 8 + i) * 72 + s] = f2bf(a0[i]); BMT[(ck * 8 + 4 + i) * 72 + s] = f2bf(a1[i]); } }
            float dt, ac; const float Ah = -expf(P.in[8][h]);
            ssd_stage_xt_dt(lds, U, AUX, cw, cb, P.in[7][h], Ah, t0, h, wave, lane, dt, ac);
            const float ac63 = __shfl(ac, 63);
            float* SW = (float*)(lds + SL_SW + wave * 256);
            SW[lane] = expf(ac63 - ac) * dt;
            if (lane == 0) CD[c * 16 + h] = expf(ac63);
            __syncthreads();
            const bf16_t* XT = (const bf16_t*)(lds + SL_XT + wave * 9216);
            for (int pt = 0; pt < 4; ++pt) {
                bf16x8 af[2];
#pragma unroll
                for (int ks = 0; ks < 2; ++ks) { const bf16x8 xa = *(const bf16x8*)(XT + (pt * 16 + l15) * 72 + ks * 32 + quad * 8);
                    const f32x4 w0 = *(const f32x4*)(SW + ks * 32 + quad * 8), w1 = *(const f32x4*)(SW + ks * 32 + quad * 8 + 4);
                    u32x4 pw; pw.x = pk_bf16(s2f(xa[0]) * w0[0], s2f(xa[1]) * w0[1]); pw.y = pk_bf16(s2f(xa[2]) * w0[2], s2f(xa[3]) * w0[3]);
                    pw.z = pk_bf16(s2f(xa[4]) * w1[0], s2f(xa[5]) * w1[1]); pw.w = pk_bf16(s2f(xa[6]) * w1[2], s2f(xa[7]) * w1[3]);
                    af[ks] = __builtin_bit_cast(bf16x8, pw); }
                f32x4 acc[8];
#pragma unroll
                for (int nt = 0; nt < 8; ++nt) { acc[nt] = (f32x4){0.f, 0.f, 0.f, 0.f};
#pragma unroll
                    for (int ks = 0; ks < 2; ++ks) { const bf16x8 b = *(const bf16x8*)(BMT + (nt * 16 + l15) * 72 + ks * 32 + quad * 8);
                        acc[nt] = __builtin_amdgcn_mfma_f32_16x16x32_bf16(af[ks], b, acc[nt], 0, 0, 0); } }
#pragma unroll
                for (int nt = 0; nt < 8; ++nt)
#pragma unroll
                    for (int r = 0; r < 4; ++r) ST[((size_t)(c * 16 + h) * 64 + pt * 16 + quad * 4 + r) * 128 + nt * 16 + l15] = f2bf(acc[nt][r]);
            }
            __syncthreads();
        }
    }
    }
    GRID_BAR();

    if (PH(3)) { TVARS for (int e = gtid; e < 131072; e += nthr) {
        const int h = e >> 13; float run = 0.f;
        for (int c0 = 0; c0 < 128; c0 += 8) {
            float sv[8], dv[8];
#pragma unroll
            for (int j = 0; j < 8; ++j) { sv[j] = bf2f(ST[(size_t)(c0 + j) * 131072 + e]); dv[j] = CD[(c0 + j) * 16 + h]; }
#pragma unroll
            for (int j = 0; j < 8; ++j) { ST[(size_t)(c0 + j) * 131072 + e] = f2bf(run); run = run * dv[j] + sv[j]; }
        }
    } }
    GRID_BAR();

    { TVARS
        const float* cw = P.in[5]; const float* cb = P.in[6]; const float* nw = P.in[10];
        if (PH(4)) for (int it = bid; it < 256; it += G) {
            const int c = it >> 1, g = it & 1, t0 = c * 64, h = g * 8 + wave;
            bf16_t* CM = (bf16_t*)(lds + SL_CM); bf16_t* BM = (bf16_t*)(lds + SL_BM); float* GG = (float*)(lds + SL_GG);
            for (int idx = tid; idx < 2048; idx += NTHREADS) { const int which = idx >> 10, s = (idx >> 4) & 63, ck = idx & 15; f32x4 a0, a1;
                conv4_silu8(U, t0 + s, 1024 + which * 256 + g * 128 + ck * 8, cw, cb, a0, a1);
                *(u32x4*)((which ? CM : BM) + s * 136 + ck * 8) = pk8(a0, a1); }
            float dt, ac; const float Ah = -expf(P.in[8][h]);
            ssd_stage_xt_dt(lds, U, AUX, cw, cb, P.in[7][h], Ah, t0, h, wave, lane, dt, ac);
            float* SDT = (float*)(lds + SL_DT + wave * 256); float* SAC = (float*)(lds + SL_AC + wave * 256);
            SDT[lane] = dt; SAC[lane] = ac;
            __syncthreads();
#pragma unroll
            for (int k2 = 0; k2 < 2; ++k2) { const int id = 2 * wave + k2, lt = id >> 2, st = id & 3; f32x4 acc = {0.f, 0.f, 0.f, 0.f};
#pragma unroll
                for (int ks = 0; ks < 4; ++ks) { const bf16x8 a = *(const bf16x8*)(CM + (lt * 16 + l15) * 136 + ks * 32 + quad * 8), b = *(const bf16x8*)(BM + (st * 16 + l15) * 136 + ks * 32 + quad * 8);
                    acc = __builtin_amdgcn_mfma_f32_16x16x32_bf16(a, b, acc, 0, 0, 0); }
#pragma unroll
                for (int r = 0; r < 4; ++r) GG[(lt * 16 + quad * 4 + r) * 68 + st * 16 + l15] = acc[r]; }
            __syncthreads();
            const bf16_t* XT = (const bf16_t*)(lds + SL_XT + wave * 9216);
            const float Dh = P.in[9][h];
            const bf16_t* HP = ST + (size_t)(c * 16 + h) * 64 * 128;
            for (int lt = 0; lt < 4; ++lt) {
                const int la = lt * 16 + l15; const float acl = SAC[la];
                f32x4 yd[4], yo[4];
#pragma unroll
                for (int pt = 0; pt < 4; ++pt) { yd[pt] = (f32x4){0.f, 0.f, 0.f, 0.f}; yo[pt] = (f32x4){0.f, 0.f, 0.f, 0.f}; }
#pragma unroll
                for (int ks = 0; ks < 2; ++ks) {
                    if (ks * 32 <= lt * 16 + 15) {
                        const int s0 = ks * 32 + quad * 8;
                        const f32x4 g0 = *(const f32x4*)(GG + la * 68 + s0), g1 = *(const f32x4*)(GG + la * 68 + s0 + 4);
                        const f32x4 e0 = *(const f32x4*)(SAC + s0), e1 = *(const f32x4*)(SAC + s0 + 4), d0 = *(const f32x4*)(SDT + s0), d1 = *(const f32x4*)(SDT + s0 + 4);
                        float mv[8];
#pragma unroll
                        for (int j = 0; j < 4; ++j) { mv[j] = (s0 + j <= la) ? g0[j] * __expf(fminf(acl - e0[j], 0.f)) * d0[j] : 0.f; mv[4 + j] = (s0 + 4 + j <= la) ? g1[j] * __expf(fminf(acl - e1[j], 0.f)) * d1[j] : 0.f; }
                        u32x4 pw; pw.x = pk_bf16(mv[0], mv[1]); pw.y = pk_bf16(mv[2], mv[3]); pw.z = pk_bf16(mv[4], mv[5]); pw.w = pk_bf16(mv[6], mv[7]);
                        const bf16x8 a = __builtin_bit_cast(bf16x8, pw);
#pragma unroll
                        for (int pt = 0; pt < 4; ++pt) { const bf16x8 b = *(const bf16x8*)(XT + (pt * 16 + l15) * 72 + s0); yd[pt] = __builtin_amdgcn_mfma_f32_16x16x32_bf16(a, b, yd[pt], 0, 0, 0); }
                    }
                }
#pragma unroll
                for (int ks = 0; ks < 4; ++ks) { const bf16x8 a = *(const bf16x8*)(CM + la * 136 + ks * 32 + quad * 8);
#pragma unroll
                    for (int pt = 0; pt < 4; ++pt) { const bf16x8 b = *(const bf16x8*)(HP + (size_t)(pt * 16 + l15) * 128 + ks * 32 + quad * 8); yo[pt] = __builtin_amdgcn_mfma_f32_16x16x32_bf16(a, b, yo[pt], 0, 0, 0); } }
                const int lc = lt * 16 + quad * 4;
                const f32x4 eav = *(const f32x4*)(SAC + lc);
                float ea[4], rsum[4];
#pragma unroll
                for (int r = 0; r < 4; ++r) { ea[r] = __expf(eav[r]); rsum[r] = 0.f; }
#pragma unroll
                for (int pt = 0; pt < 4; ++pt) { const int p = pt * 16 + l15; const u32x2 xw = *(const u32x2*)(XT + p * 72 + lc);
                    const float xv[4] = {bf_lo(xw.x), bf_hi(xw.x), bf_lo(xw.y), bf_hi(xw.y)}; const float nwp = nw[h * 64 + p];
#pragma unroll
                    for (int r = 0; r < 4; ++r) { const int t = t0 + lc + r; float y = yd[pt][r] + ea[r] * yo[pt][r] + Dh * xv[r];
                        const float z = bf2f(U[(size_t)t * UP + 4608 + h * 64 + p]); y *= z / (1.0f + __expf(-z)); rsum[r] += y * y;
                        YC[(size_t)t * 2048 + 1024 + h * 64 + p] = f2bf(y * nwp); } }
#pragma unroll
                for (int r = 0; r < 4; ++r) { float v = rsum[r]; v += __shfl_xor(v, 1); v += __shfl_xor(v, 2); v += __shfl_xor(v, 4); v += __shfl_xor(v, 8); if (l15 == 0) unsafeAtomicAdd(RSS + t0 + lc + r, v); }
            }
            __syncthreads();
        }
#ifndef REP_ATT
#define REP_ATT 1
#endif
        if (PH(12)) for (int rep = 0; rep < REP_ATT; ++rep) for (int it = bid; it < 256; it += G) { const int h = it >> 4, s = it & 15;
            fox_unit(lds, U, Vt, CL, YC, h, 31 - s);
            fox_unit(lds, U, Vt, CL, YC, h, s); }
    }
    GRID_BAR();

    if (PH(5)) { TVARS for (int i = gtid; i < SEQ * 128; i += nthr) { const int row = i >> 7, ck = i & 127; const float rs = 1.0f / sqrtf(RSS[row] * (1.0f / 1024.0f) + 1e-6f);
        bf16_t* p = YC + (size_t)row * 2048 + 1024 + ck * 8; const u32x4 v = *(const u32x4*)p;
        u32x4 o; o.x = pk_bf16(bf_lo(v.x) * rs, bf_hi(v.x) * rs); o.y = pk_bf16(bf_lo(v.y) * rs, bf_hi(v.y) * rs); o.z = pk_bf16(bf_lo(v.z) * rs, bf_hi(v.z) * rs); o.w = pk_bf16(bf_lo(v.w) * rs, bf_hi(v.w) * rs);
        *(u32x4*)p = o; } }
    GRID_BAR();

    if (PH(6)) {
        pg8::Gemm g{YC, Wout_t, SEQ, DM, DM, DM}; pg8::StaticOrder S; S.init(SEQ, DM, G, bid);
        pg8::EpiRes<0> E{x, out, XW, P.in[12], RS1, nullptr, nullptr};
        pg8::gemm_phase<pg8::EpiRes<0>, pg8::StaticOrder, true, true>(glds, g, S, E);
    }
    GRID_BAR();

#ifndef REP_GU
#define REP_GU 1
#endif
    if (PH(7)) {
        pg8::Gemm g{XW, Wgu_t, SEQ, GUP, DM, DM}; pg8::StaticOrder S; S.init(SEQ, GUP, G, bid);
        pg8::EpiRowScaleBf16 E{GU, GUP, RS1};
        pg8::gemm_phase<pg8::EpiRowScaleBf16, pg8::StaticOrder, true, true>(glds, g, S, E);
    }
    GRID_BAR();

#if REP_GU > 1
    {
        pg8::Gemm g{XW, Wgu_t, SEQ, GUP, DM, DM}; pg8::StaticOrder S; S.init(SEQ, GUP, G, bid);
        pg8::EpiRowScaleBf16 E{GU, GUP, RS1};
        pg8::gemm_phase<pg8::EpiRowScaleBf16, pg8::StaticOrder, true, true>(glds, g, S, E);
    }
    GRID_BAR();
#endif
    if (PH(8)) { TVARS
        const float* fw = P.in[14]; const float* fb = P.in[15];
        for (int it = gtid; it < 704 * 256; it += nthr) {
            const int ck = it % 704, seg = it / 704, tb = seg * 32, col = ck * 8;
            f32x4 w0a = *(const f32x4*)(fw + col), w0b = *(const f32x4*)(fw + col + 4), w1a = *(const f32x4*)(fw + DFF + col), w1b = *(const f32x4*)(fw + DFF + col + 4);
            f32x4 w2a = *(const f32x4*)(fw + 2 * DFF + col), w2b = *(const f32x4*)(fw + 2 * DFF + col + 4), ba = *(const f32x4*)(fb + col), bb = *(const f32x4*)(fb + col + 4);
            u32x4 gm2 = {0u, 0u, 0u, 0u}, gm1 = {0u, 0u, 0u, 0u};
            if (tb > 0) { gm2 = *(const u32x4*)(GU + (size_t)(tb - 2) * GUP + col); gm1 = *(const u32x4*)(GU + (size_t)(tb - 1) * GUP + col); }
            for (int t = tb; t < tb + 32; ++t) {
                const u32x4 g0 = *(const u32x4*)(GU + (size_t)t * GUP + col); const u32x4 uu = *(const u32x4*)(GU + (size_t)t * GUP + DFF + col);
                f32x4 va, vb;
                va[0] = ba[0] + w0a[0] * bf_lo(gm2.x) + w1a[0] * bf_lo(gm1.x) + w2a[0] * bf_lo(g0.x); va[1] = ba[1] + w0a[1] * bf_hi(gm2.x) + w1a[1] * bf_hi(gm1.x) + w2a[1] * bf_hi(g0.x);
                va[2] = ba[2] + w0a[2] * bf_lo(gm2.y) + w1a[2] * bf_lo(gm1.y) + w2a[2] * bf_lo(g0.y); va[3] = ba[3] + w0a[3] * bf_hi(gm2.y) + w1a[3] * bf_hi(gm1.y) + w2a[3] * bf_hi(g0.y);
                vb[0] = bb[0] + w0b[0] * bf_lo(gm2.z) + w1b[0] * bf_lo(gm1.z) + w2b[0] * bf_lo(g0.z); vb[1] = bb[1] + w0b[1] * bf_hi(gm2.z) + w1b[1] * bf_hi(gm1.z) + w2b[1] * bf_hi(g0.z);
                vb[2] = bb[2] + w0b[2] * bf_lo(gm2.w) + w1b[2] * bf_lo(gm1.w) + w2b[2] * bf_lo(g0.w); vb[3] = bb[3] + w0b[3] * bf_hi(gm2.w) + w1b[3] * bf_hi(gm1.w) + w2b[3] * bf_hi(g0.w);
                const f32x4 ua = {bf_lo(uu.x), bf_hi(uu.x), bf_lo(uu.y), bf_hi(uu.y)}, ub = {bf_lo(uu.z), bf_hi(uu.z), bf_lo(uu.w), bf_hi(uu.w)};
#pragma unroll
                for (int i = 0; i < 4; ++i) { va[i] = va[i] / (1.0f + __expf(-va[i])) * ua[i]; vb[i] = vb[i] / (1.0f + __expf(-vb[i])) * ub[i]; }
                *(u32x4*)(GU + (size_t)t * GUP + DFF + col) = pk8(va, vb);
                gm2 = gm1; gm1 = g0;
            }
        }
    }
    GRID_BAR();

    if (PH(9)) {
        pg8::Gemm g{GU + DFF, Wd_t, SEQ, DM, DFF, GUP}; pg8::StaticOrder S; S.init(SEQ, DM, G, bid);
        pg8::EpiRes<1> E{out, out, XW, P.in[17], RS2, nullptr, nullptr};
        pg8::gemm_phase<pg8::EpiRes<1>, pg8::StaticOrder, true, true>(glds, g, S, E);
    }
    GRID_BAR();

    if (PH(10)) {
        pg8::Gemm g{XW, Wpg_t, SEQ, DM, DM, DM}; pg8::StaticOrder S; S.init(SEQ, DM, G, bid);
        pg8::EpiRes<2> E{out, out, nullptr, nullptr, RS3, RS2, PP};
        pg8::gemm_phase<pg8::EpiRes<2>, pg8::StaticOrder, true, true>(glds, g, S, E);
    }
    GRID_BAR();

    if (PH(11)) { TVARS
        const float* fnw = P.in[20];
        for (int i = gtid; i < SEQ * 512; i += nthr) { const int row = i >> 9, c4 = i & 511; const float rs = 1.0f / sqrtf(RS3[row] * (1.0f / 2048.0f) + 1e-6f);
            f32x4* p = (f32x4*)(out + (size_t)row * DM) + c4; const f32x4 w = ((const f32x4*)fnw)[c4]; *p = (*p) * rs * w; }
    }
}

extern "C" void kernel_launch(void* const* d_in, const int* in_sizes, int n_in, void* d_out, int out_size, void* d_ws, size_t ws_size, hipStream_t stream) {
    static int grid = 0;
    if (grid == 0) {
        if (n_in != 21 || out_size != SEQ * DM || ws_size < WS_END) { fprintf(stderr, "kernel_launch: unexpected problem (n_in %d, out %d, ws %zu)\n", n_in, out_size, ws_size); grid = -1; return; }
        int dev = 0, cus = 0, per_cu = 0;
        hipGetDevice(&dev); hipDeviceGetAttribute(&cus, hipDeviceAttributeMultiprocessorCount, dev);
        hipFuncSetAttribute((const void*)fwd_megakernel, hipFuncAttributeMaxDynamicSharedMemorySize, LDS_BYTES);
        hipOccupancyMaxActiveBlocksPerMultiprocessor(&per_cu, (const void*)fwd_megakernel, NTHREADS, LDS_BYTES);
        if (per_cu < 1) { fprintf(stderr, "kernel_launch: occupancy query says %d blocks per CU\n", per_cu); per_cu = 1; }
        (void)hipGetLastError();
        grid = cus;
    }
    if (grid < 0) return;
    Params p{};
    for (int i = 0; i < 21; ++i) p.in[i] = (const float*)d_in[i];
    p.out = (float*)d_out; p.ws = (unsigned char*)d_ws;
    if (hipMemsetAsync((char*)d_ws + WS_BAR, 0, BAR_BYTES, stream) != hipSuccess) { fprintf(stderr, "kernel_launch: memset of barrier words failed\n"); return; }
    void* args[] = {&p};
    hipError_t e = hipLaunchCooperativeKernel((const void*)fwd_megakernel, dim3(grid), dim3(NTHREADS), args, LDS_BYTES, stream);
    if (e != hipSuccess) fprintf(stderr, "cooperative launch failed: %s (grid %d)\n", hipGetErrorString(e), grid);
}
```

```cpp
#include <hip/hip_runtime.h>
#include <hip/hip_cooperative_groups.h>
#include <cstdio>
#include <cstdint>
namespace cg = cooperative_groups;
namespace pg8 {
#define PG8_LAS __attribute__((address_space(3)))
typedef unsigned short bf16_t;
typedef short bf16x8 __attribute__((ext_vector_type(8)));
typedef float f32x4 __attribute__((ext_vector_type(4)));
typedef unsigned u32x4 __attribute__((ext_vector_type(4)));
constexpr int BM = 256, BK = 64, HALF = 128, HTB = HALF * BK * 2  , STAGE_BYTES = 8 * HTB, NXCD = 8, WGM = 8;

__host__ __device__ __forceinline__ int lds_byte(int r, int c) { const int st = (r >> 4) * 2 + (c >> 5), rr = r & 15, cc = c & 31, ob = rr * 64 + cc * 2; return st * 1024 + (ob ^ (((ob >> 9) & 1) << 5)); }
__host__ __device__ __forceinline__ void stage_rc(int b, int& R, int& C) { const int st = b / 1024, sb = b % 1024, swz = sb ^ (((sb >> 9) & 1) << 5); R = (st >> 1) * 16 + swz / 64; C = (st & 1) * 32 + (swz % 64) / 2; }
__host__ __device__ __forceinline__ int perm32(int rho) { const int n = rho >> 4, i = rho & 15; return 8 * (i >> 2) + 4 * n + (i & 3); }

struct Unit { int pm, pn; };
struct Gemm { const bf16_t* A; const bf16_t* Bt; int M, N, K, lda; };

struct StaticOrder {
    int nM, nN, nwg, G, c;
    __host__ __device__ void init(int M, int N, int G_, int c_) { nM = M / BM; nN = N / BM; nwg = nM * nN; G = G_; c = c_; }
    __host__ __device__ bool next(int i, Unit& u) const {
        const long L = (long)i * G + c; if (L >= nwg) return false;
        int wgid = (int)L; { const int q = nwg / NXCD, r = nwg % NXCD, xcd = wgid % NXCD, off = wgid / NXCD; wgid = (xcd < r ? xcd * (q + 1) : r * (q + 1) + (xcd - r) * q) + off; }
        const int nig = WGM * nN, gid = wgid / nig, fm = gid * WGM, gsz = (nM - fm) < WGM ? (nM - fm) : WGM;
        u.pm = fm + ((wgid % nig) % gsz); u.pn = (wgid % nig) / gsz; return true;
    }
    __device__ __forceinline__ void a_ready(const Unit&) const {}
    __device__ __forceinline__ void done(const Unit&) const {}
};

__device__ __forceinline__ unsigned cvt_pk_bf16(float lo, float hi) { unsigned r; asm volatile("v_cvt_pk_bf16_f32 %0, %1, %2" : "=v"(r) : "v"(lo), "v"(hi)); return r; }
typedef float f32x2 __attribute__((ext_vector_type(2)));
__device__ __forceinline__ f32x2 gelu_pk(f32x2 v) {
    const f32x2 av = __builtin_elementwise_abs(v), d = av * 0.2316418882f + 1.0f;
    f32x2 t; t.x = __builtin_amdgcn_rcpf(d.x); t.y = __builtin_amdgcn_rcpf(d.y);
    f32x2 q = t * 0.5307027145f + (-0.7265760135f); q = q * t + 0.7107068705f; q = q * t + (-0.142248368f); q = q * t + 0.127414796f; q = q * t;
    const f32x2 s = (v * v) * (-0.72134752044f);
    f32x2 e; e.x = __builtin_amdgcn_exp2f(s.x); e.y = __builtin_amdgcn_exp2f(s.y);
    const f32x2 m = v * (q * e), r = v - m;
    f32x2 o; o.x = v.x < 0.f ? m.x : r.x; o.y = v.y < 0.f ? m.y : r.y; return o;
}

template <int ACT  > struct EpiBf16 {
    static constexpr bool PERM = true, AFTER_DRAIN = false; static_assert(ACT == 0 || ACT == 1, "EpiBf16: ACT is 0 (none) or 1 (gelu_pk)");
    bf16_t* O; int ldc; const float* bias; int split_cols; size_t split_stride; float scale0;
    __device__ __forceinline__ void operator()(const f32x4 (&acc)[2][2][4][2], const Unit& u, int wr, int wc, int fr, int fq) const {
        const int row0 = u.pm * BM + wr * 64 + fr; int colt = u.pn * BM; bf16_t* base = O;
        float sc = 1.f; if (split_cols) { const int t = colt / split_cols; base += (size_t)t * split_stride; colt -= t * split_cols; if (t == 0) sc = scale0; }
        const int col0 = colt + wc * 32 + 8 * fq, bcol0 = u.pn * BM + wc * 32 + 8 * fq;
        f32x4 bv[2][2];
#pragma unroll
        for (int bj = 0; bj < 2; ++bj)
#pragma unroll
            for (int n = 0; n < 2; ++n) bv[bj][n] = bias ? *(const f32x4*)(bias + bcol0 + bj * HALF + 4 * n) : (f32x4){0.f, 0.f, 0.f, 0.f};
#pragma unroll
        for (int ai = 0; ai < 2; ++ai)
#pragma unroll
            for (int m = 0; m < 4; ++m) { bf16_t* rowp = base + (size_t)(row0 + ai * HALF + m * 16) * ldc + col0;
#pragma unroll
                for (int bj = 0; bj < 2; ++bj) { f32x4 v0 = acc[ai][bj][m][0] + bv[bj][0], v1 = acc[ai][bj][m][1] + bv[bj][1];
                    if (ACT == 1) { f32x2 a = gelu_pk((f32x2){v0[0], v0[1]}), b = gelu_pk((f32x2){v0[2], v0[3]}), c = gelu_pk((f32x2){v1[0], v1[1]}), d = gelu_pk((f32x2){v1[2], v1[3]});
                        v0 = (f32x4){a.x, a.y, b.x, b.y}; v1 = (f32x4){c.x, c.y, d.x, d.y}; }
                    v0 = v0 * sc; v1 = v1 * sc; u32x4 w; w.x = cvt_pk_bf16(v0[0], v0[1]); w.y = cvt_pk_bf16(v0[2], v0[3]); w.z = cvt_pk_bf16(v1[0], v1[1]); w.w = cvt_pk_bf16(v1[2], v1[3]);
                    *(u32x4*)(rowp + bj * HALF) = w; } }
    }
};
template <class Epi, class Sched, bool ALIGN_EPI = false, bool SP2 = false>
__device__ __forceinline__ void gemm_phase(PG8_LAS unsigned char* lds, const Gemm g, const Sched& S, const Epi& E) {
    const int tid = threadIdx.x, wid = __builtin_amdgcn_readfirstlane(tid >> 6), lane = tid & 63, wr = wid >> 2, wc = wid & 3, fr = lane & 15, fq = lane >> 4;
    const int K = g.K, nt = K / BK;
    unsigned voffA[2], voffB[2];
#pragma unroll
    for (int i = 0; i < 2; ++i) { int R, C; stage_rc(tid * 16 + i * 8192, R, C); const int Rb = Epi::PERM ? ((R & ~31) + perm32(R & 31)) : R;
        voffA[i] = (unsigned)(R * g.lda + C) * 2u; voffB[i] = (unsigned)(Rb * K + C) * 2u; }
    const size_t kstep = (size_t)(BK * 2);
    const size_t hstepA = (size_t)HALF * g.lda * 2, hstepB = (size_t)HALF * K * 2;
    const size_t tstepA = 2 * hstepA, tstepB = 2 * hstepB;
    const unsigned ldsw = (unsigned)wid * 1024u;
    const int aoff = lds_byte(wr * 64 + fr, fq * 8), boff = lds_byte(wc * 32 + fr, fq * 8);
#define PG8_SA(b, h) (((b) * 2 + (h)) * HTB)
#define PG8_SB(b, h) ((4 + (b) * 2 + (h)) * HTB)
#define PG8_STAGE(bufoff, gbase, voff) do { _Pragma("unroll") for (int _i = 0; _i < 2; ++_i) \
        __builtin_amdgcn_global_load_lds((const unsigned*)((const char*)(gbase) + (voff)[_i]), (PG8_LAS unsigned*)(lds + (bufoff) + ldsw + _i * 8192), 16, 0, 0); } while (0)
#define PG8_LDA(dst, b, h) do { _Pragma("unroll") for (int m = 0; m < 4; ++m) _Pragma("unroll") for (int k = 0; k < 2; ++k) dst[m][k] = *(const PG8_LAS bf16x8*)(lds + PG8_SA(b, h) + aoff + m * 2048 + k * 1024); } while (0)
#define PG8_LDB(dst, b, h) do { _Pragma("unroll") for (int n = 0; n < 2; ++n) _Pragma("unroll") for (int k = 0; k < 2; ++k) dst[n][k] = *(const PG8_LAS bf16x8*)(lds + PG8_SB(b, h) + boff + n * 2048 + k * 1024); } while (0)
#define PG8_MMA(ai, bj, At, Bt) do { __builtin_amdgcn_s_setprio(1); _Pragma("unroll") for (int m = 0; m < 4; ++m) _Pragma("unroll") for (int n = 0; n < 2; ++n) _Pragma("unroll") for (int k = 0; k < 2; ++k) \
        acc[ai][bj][m][n] = __builtin_amdgcn_mfma_f32_16x16x32_bf16(Bt[n][k], At[m][k], acc[ai][bj][m][n], 0, 0, 0); __builtin_amdgcn_s_setprio(0); } while (0)
#define PG8_WAIT_V(n) asm volatile("s_waitcnt vmcnt(" #n ")" ::: "memory")
#define PG8_WAIT_L(n) asm volatile("s_waitcnt lgkmcnt(" #n ")" ::: "memory")
#define PG8_BAR __builtin_amdgcn_s_barrier()
#define PG8_SCHED __builtin_amdgcn_sched_barrier(0)
    Unit cur, nxt; int ui = 0;
    if (!S.next(0, cur)) return;
    f32x4 acc[2][2][4][2];
#pragma unroll
    for (int a = 0; a < 2; ++a)
#pragma unroll
        for (int b = 0; b < 2; ++b)
#pragma unroll
            for (int m = 0; m < 4; ++m)
#pragma unroll
                for (int n = 0; n < 2; ++n) acc[a][b][m][n] = (f32x4){0.f, 0.f, 0.f, 0.f};
    bf16x8 At[4][2], B0[2][2], B1[2][2];
    const char* cA = (const char*)g.A + (size_t)cur.pm * tstepA; const char* cB = (const char*)g.Bt + (size_t)cur.pn * tstepB;
    S.a_ready(cur);
    if constexpr (SP2) {
        PG8_STAGE(PG8_SB(0, 0), cB, voffB); PG8_STAGE(PG8_SB(0, 1), cB + hstepB, voffB); PG8_STAGE(PG8_SA(0, 0), cA, voffA); PG8_STAGE(PG8_SA(0, 1), cA + hstepA, voffA);
        if (wr == 1) PG8_BAR;
        PG8_WAIT_V(2); PG8_BAR;
        PG8_STAGE(PG8_SB(1, 0), cB + kstep, voffB); PG8_STAGE(PG8_SA(1, 0), cA + kstep, voffA); PG8_STAGE(PG8_SB(1, 1), cB + hstepB + kstep, voffB);
        PG8_WAIT_V(6); PG8_BAR;
    } else {
        PG8_STAGE(PG8_SB(0, 0), cB, voffB); PG8_STAGE(PG8_SA(0, 0), cA, voffA); PG8_STAGE(PG8_SB(0, 1), cB + hstepB, voffB); PG8_STAGE(PG8_SA(0, 1), cA + hstepA, voffA);
        if (wr == 1) PG8_BAR;
        PG8_WAIT_V(4); PG8_BAR;
        PG8_STAGE(PG8_SB(1, 0), cB + kstep, voffB); PG8_STAGE(PG8_SA(1, 0), cA + kstep, voffA); PG8_STAGE(PG8_SB(1, 1), cB + hstepB + kstep, voffB);
        PG8_WAIT_V(6); PG8_BAR;
    }
    for (;;) {
        const bool has_next = S.next(ui + 1, nxt);
        const char* nA = has_next ? (const char*)g.A + (size_t)nxt.pm * tstepA : cA; const char* nB = has_next ? (const char*)g.Bt + (size_t)nxt.pn * tstepB : cB;
        for (int t = 0; t < nt; t += 2) {
            const bool last = (t == nt - 2);
            const char* a1 = cA + (size_t)(t + 1) * kstep;
            const char* a2 = last ? nA : cA + (size_t)(t + 2) * kstep; const char* b2 = last ? nB : cB + (size_t)(t + 2) * kstep;
            const char* a3 = a2 + kstep; const char* b3 = b2 + kstep;
            if (last && has_next) S.a_ready(nxt);
            if constexpr (SP2) {
            PG8_LDB(B0, 0, 0); PG8_LDB(B1, 0, 1); PG8_SCHED; PG8_LDA(At, 0, 0); PG8_STAGE(PG8_SA(1, 1), a1 + hstepA, voffA);
            PG8_WAIT_V(8); PG8_WAIT_L(0); PG8_BAR; PG8_MMA(0, 0, At, B0); PG8_MMA(0, 1, At, B1); PG8_BAR; PG8_SCHED;
            PG8_LDA(At, 0, 1); PG8_STAGE(PG8_SB(0, 0), b2, voffB); PG8_STAGE(PG8_SB(0, 1), b2 + hstepB, voffB); PG8_STAGE(PG8_SA(0, 0), a2, voffA);
            PG8_WAIT_V(8); PG8_WAIT_L(0); PG8_BAR; PG8_MMA(1, 0, At, B0); PG8_MMA(1, 1, At, B1); PG8_BAR; PG8_SCHED;
            PG8_LDB(B0, 1, 0); PG8_LDB(B1, 1, 1); PG8_SCHED; PG8_LDA(At, 1, 0); PG8_STAGE(PG8_SA(0, 1), a2 + hstepA, voffA);
            PG8_WAIT_V(8); PG8_WAIT_L(0); PG8_BAR; PG8_MMA(0, 0, At, B0); PG8_MMA(0, 1, At, B1); PG8_BAR; PG8_SCHED;
            PG8_LDA(At, 1, 1); PG8_STAGE(PG8_SB(1, 0), b3, voffB); PG8_STAGE(PG8_SB(1, 1), b3 + hstepB, voffB); PG8_STAGE(PG8_SA(1, 0), a3, voffA);
            PG8_WAIT_V(8); PG8_WAIT_L(0); PG8_BAR; PG8_MMA(1, 0, At, B0); PG8_MMA(1, 1, At, B1); PG8_BAR; PG8_SCHED;
            } else {
            PG8_LDB(B0, 0, 0); PG8_SCHED; PG8_LDA(At, 0, 0); PG8_STAGE(PG8_SA(1, 1), a1 + hstepA, voffA);
            PG8_WAIT_L(8); PG8_BAR; PG8_WAIT_L(0); PG8_MMA(0, 0, At, B0); PG8_BAR; PG8_SCHED;
            PG8_LDB(B1, 0, 1); PG8_STAGE(PG8_SB(0, 0), b2, voffB);
            PG8_BAR; PG8_WAIT_L(0); PG8_MMA(0, 1, At, B1); PG8_BAR;
            PG8_LDA(At, 0, 1); PG8_STAGE(PG8_SA(0, 0), a2, voffA);
            PG8_BAR; PG8_WAIT_L(0); PG8_MMA(1, 0, At, B0); PG8_BAR; PG8_SCHED;
            PG8_STAGE(PG8_SB(0, 1), b2 + hstepB, voffB);
            PG8_WAIT_V(6); PG8_BAR; PG8_MMA(1, 1, At, B1); PG8_BAR;
            PG8_LDB(B0, 1, 0); PG8_SCHED; PG8_LDA(At, 1, 0); PG8_STAGE(PG8_SA(0, 1), a2 + hstepA, voffA);
            PG8_WAIT_L(8); PG8_BAR; PG8_WAIT_L(0); PG8_MMA(0, 0, At, B0); PG8_BAR; PG8_SCHED;
            PG8_LDB(B1, 1, 1); PG8_STAGE(PG8_SB(1, 0), b3, voffB);
            PG8_BAR; PG8_WAIT_L(0); PG8_MMA(0, 1, At, B1); PG8_BAR;
            PG8_LDA(At, 1, 1); PG8_STAGE(PG8_SA(1, 0), a3, voffA);
            PG8_BAR; PG8_WAIT_L(0); PG8_MMA(1, 0, At, B0); PG8_BAR; PG8_SCHED;
            PG8_STAGE(PG8_SB(1, 1), b3 + hstepB, voffB);
            PG8_WAIT_V(6); PG8_BAR; PG8_MMA(1, 1, At, B1); PG8_BAR;
            }
        }
        if constexpr (ALIGN_EPI) { if (wr == 0) PG8_BAR; }
        if constexpr (!Epi::AFTER_DRAIN) { E(acc, cur, wr, wc, fr, fq); S.done(cur); }
        if (!has_next) break;
#pragma unroll
        for (int a = 0; a < 2; ++a)
#pragma unroll
            for (int b = 0; b < 2; ++b)
#pragma unroll
                for (int m = 0; m < 4; ++m)
#pragma unroll
                    for (int n = 0; n < 2; ++n) acc[a][b][m][n] = (f32x4){0.f, 0.f, 0.f, 0.f};
        cur = nxt; cA = nA; cB = nB; ++ui;
        if constexpr (ALIGN_EPI) { if (wr == 1) PG8_BAR; }
    }
    PG8_WAIT_V(0);
    if constexpr (!ALIGN_EPI) { if (wr == 0) PG8_BAR; }
    PG8_BAR;
    if constexpr (Epi::AFTER_DRAIN) { E.fused(acc, cur, wr, wc, fr, fq, lds, wid, lane); S.done(cur); }
#undef PG8_SA
#undef PG8_SB
#undef PG8_STAGE
#undef PG8_LDA
#undef PG8_LDB
#undef PG8_MMA
#undef PG8_WAIT_V
#undef PG8_WAIT_L
#undef PG8_BAR
#undef PG8_SCHED
}
}

namespace pg8 {
typedef unsigned u32x2v __attribute__((ext_vector_type(2)));
__device__ __forceinline__ unsigned pk_bf16(float lo, float hi) { typedef float f2 __attribute__((ext_vector_type(2))); typedef __bf16 b2 __attribute__((ext_vector_type(2))); f2 v = {lo, hi}; b2 b = __builtin_convertvector(v, b2); return __builtin_bit_cast(unsigned, b); }
__device__ __forceinline__ float bf_lo(unsigned w) { return __uint_as_float(w << 16); }
__device__ __forceinline__ float bf_hi(unsigned w) { return __uint_as_float(w & 0xffff0000u); }
__device__ __forceinline__ u32x4 pk8(f32x4 a, f32x4 b) { u32x4 w; w.x = pk_bf16(a[0], a[1]); w.y = pk_bf16(a[2], a[3]); w.z = pk_bf16(b[0], b[1]); w.w = pk_bf16(b[2], b[3]); return w; }

struct EpiInProj {
    static constexpr bool PERM = true, AFTER_DRAIN = false;
    bf16_t* U; float* AUX; float qscale;
    __device__ __forceinline__ void operator()(const f32x4 (&acc)[2][2][4][2], const Unit& u, int wr, int wc, int fr, int fq) const {
        const int row0 = u.pm * BM + wr * 64 + fr;
        if (u.pn < 22) {
            const float sc = (u.pn < 4) ? qscale : 1.f;
            const int col0 = u.pn * BM + wc * 32 + 8 * fq;
#pragma unroll
            for (int ai = 0; ai < 2; ++ai)
#pragma unroll
                for (int m = 0; m < 4; ++m) { bf16_t* rowp = U + (size_t)(row0 + ai * HALF + m * 16) * 5632 + col0;
#pragma unroll
                    for (int bj = 0; bj < 2; ++bj) *(u32x4*)(rowp + bj * HALF) = pk8(acc[ai][bj][m][0] * sc, acc[ai][bj][m][1] * sc); }
        } else if (wc == 0) {
#pragma unroll
            for (int ai = 0; ai < 2; ++ai)
#pragma unroll
                for (int m = 0; m < 4; ++m) { float* rp = AUX + (size_t)(row0 + ai * HALF + m * 16) * 32 + 8 * fq;
                    *(f32x4*)rp = acc[ai][0][m][0]; *(f32x4*)(rp + 4) = acc[ai][0][m][1]; }
        }
    }
};
struct EpiPlainBf16 {
    static constexpr bool PERM = true, AFTER_DRAIN = false;
    bf16_t* O; int ldc;
    __device__ __forceinline__ void operator()(const f32x4 (&acc)[2][2][4][2], const Unit& u, int wr, int wc, int fr, int fq) const {
        const int row0 = u.pm * BM + wr * 64 + fr; const int col0 = u.pn * BM + wc * 32 + 8 * fq;
#pragma unroll
        for (int ai = 0; ai < 2; ++ai)
#pragma unroll
            for (int m = 0; m < 4; ++m) { bf16_t* rowp = O + (size_t)(row0 + ai * HALF + m * 16) * ldc + col0;
#pragma unroll
                for (int bj = 0; bj < 2; ++bj) *(u32x4*)(rowp + bj * HALF) = pk8(acc[ai][bj][m][0], acc[ai][bj][m][1]); }
    }
};
struct EpiRowScaleBf16 {
    static constexpr bool PERM = true, AFTER_DRAIN = false;
    bf16_t* O; int ldc; const float* rowsq;
    __device__ __forceinline__ void operator()(const f32x4 (&acc)[2][2][4][2], const Unit& u, int wr, int wc, int fr, int fq) const {
        const int row0 = u.pm * BM + wr * 64 + fr; const int col0 = u.pn * BM + wc * 32 + 8 * fq;
#pragma unroll
        for (int ai = 0; ai < 2; ++ai)
#pragma unroll
            for (int m = 0; m < 4; ++m) { const int row = row0 + ai * HALF + m * 16; const float rs = 1.0f / sqrtf(rowsq[row] * (1.0f / 2048.0f) + 1e-6f);
                bf16_t* rowp = O + (size_t)row * ldc + col0;
#pragma unroll
                for (int bj = 0; bj < 2; ++bj) *(u32x4*)(rowp + bj * HALF) = pk8(acc[ai][bj][m][0] * rs, acc[ai][bj][m][1] * rs); }
    }
};
template <int MODE> struct EpiRes {
    static constexpr bool PERM = true, AFTER_DRAIN = false;
    const float* base; float* out; bf16_t* XW; const float* nw; float* rowsq_out; const float* rowsq_in; const bf16_t* PP;
    __device__ __forceinline__ void operator()(const f32x4 (&acc)[2][2][4][2], const Unit& u, int wr, int wc, int fr, int fq) const {
        const int row0 = u.pm * BM + wr * 64 + fr; const int col0 = u.pn * BM + wc * 32 + 8 * fq;
        f32x4 nwv[2][2];
#pragma unroll
        for (int bj = 0; bj < 2; ++bj)
#pragma unroll
            for (int n = 0; n < 2; ++n) nwv[bj][n] = (MODE != 2) ? *(const f32x4*)(nw + col0 + bj * HALF + 4 * n) : (f32x4){0.f, 0.f, 0.f, 0.f};
#pragma unroll
        for (int ai = 0; ai < 2; ++ai)
#pragma unroll
            for (int m = 0; m < 4; ++m) {
                const int row = row0 + ai * HALF + m * 16; const size_t off = (size_t)row * 2048 + col0;
                float rs = 0.f; if (MODE == 2) rs = 1.0f / sqrtf(rowsq_in[row] * (1.0f / 2048.0f) + 1e-6f);
                float ss = 0.f;
#pragma unroll
                for (int bj = 0; bj < 2; ++bj) {
                    const f32x4 b0 = *(const f32x4*)(base + off + bj * HALF), b1 = *(const f32x4*)(base + off + bj * HALF + 4);
                    f32x4 a0 = acc[ai][bj][m][0], a1 = acc[ai][bj][m][1];
                    if (MODE == 2) {
                        const u32x4 pw = *(const u32x4*)(PP + off + bj * HALF);
                        const f32x4 p0 = {bf_lo(pw.x), bf_hi(pw.x), bf_lo(pw.y), bf_hi(pw.y)}, p1 = {bf_lo(pw.z), bf_hi(pw.z), bf_lo(pw.w), bf_hi(pw.w)};
#pragma unroll
                        for (int i = 0; i < 4; ++i) { a0[i] = p0[i] / (1.0f + __expf(-rs * a0[i])); a1[i] = p1[i] / (1.0f + __expf(-rs * a1[i])); }
                    }
                    const f32x4 x0 = b0 + a0, x1 = b1 + a1;
                    *(f32x4*)(out + off + bj * HALF) = x0; *(f32x4*)(out + off + bj * HALF + 4) = x1;
                    ss += (x0[0] * x0[0] + x0[1] * x0[1]) + (x0[2] * x0[2] + x0[3] * x0[3]) + (x1[0] * x1[0] + x1[1] * x1[1]) + (x1[2] * x1[2] + x1[3] * x1[3]);
                    if (MODE != 2) *(u32x4*)(XW + off + bj * HALF) = pk8(x0 * nwv[bj][0], x1 * nwv[bj][1]);
                }
                ss += __shfl_xor(ss, 16); ss += __shfl_xor(ss, 32);
                if (fq == 0) unsafeAtomicAdd(rowsq_out + row, ss);
            }
    }
};
}

using pg8::bf16_t; using pg8::bf16x8; using pg8::f32x4; using pg8::u32x4; using pg8::pk_bf16; using pg8::pk8; using pg8::bf_lo; using pg8::bf_hi;
typedef float f32x16 __attribute__((ext_vector_type(16)));
typedef unsigned u32x2 __attribute__((ext_vector_type(2)));
typedef short s16x4 __attribute__((ext_vector_type(4)));
constexpr int SEQ = 8192, DM = 2048, UP = 5632, NIN = 5888, DFF = 5632, GUP = 11264;
constexpr float LOG2E = 1.4426950408889634f;
constexpr float QSCALE = 0.125f * LOG2E;
constexpr size_t MiB = 1u << 20;
constexpr size_t WS_RS1 = 0, WS_RS2 = 32768, WS_RS3 = 65536, WS_RSS = 98304, WS_CD = 131072, WS_CL = 262144, WS_AUX = 1 * MiB;
constexpr size_t WS_BAR = 2 * MiB, BAR_BYTES = 16384;
constexpr size_t WS_WGU = 4 * MiB, WS_WD = 48 * MiB, WS_WPG = 70 * MiB, WS_WPP = 78 * MiB, WS_XW = 79 * MiB, WS_PP = 111 * MiB;
constexpr size_t WS_WIN = 143 * MiB, WS_WOUT = 166 * MiB, WS_P16 = 174 * MiB, WS_U = 178 * MiB, WS_VT = 266 * MiB, WS_ST = 282 * MiB, WS_YC = 314 * MiB, WS_GU = 143 * MiB;
constexpr size_t WS_END = 346 * MiB;
constexpr int LDS_BYTES = 147456;
constexpr int NTHREADS = 512;

__device__ __forceinline__ float bf2f(bf16_t b) { return __uint_as_float((unsigned)b << 16); }
__device__ __forceinline__ bf16_t f2bf(float f) { return (bf16_t)(pk_bf16(f, 0.f) & 0xffffu); }
__device__ __forceinline__ float s2f(short s) { return __uint_as_float(((unsigned)(unsigned short)s) << 16); }
__device__ __forceinline__ float wave_sum(float v) {
#pragma unroll
    for (int o = 1; o < 64; o <<= 1) v += __shfl_xor(v, o);
    return v;
}
#define LDS_WAIT() asm volatile("s_waitcnt lgkmcnt(0)" ::: "memory")
#define LAS __attribute__((address_space(3)))

__device__ __forceinline__ int inproj_src(int np) { if (np < 3072) return np; if (np < 5632) return np + 16; if (np < 5648) return 3072 + (np - 5632); if (np < 5664) return np; return -1; }

template <bool MAP> __device__ __forceinline__ void transpose_item(const float* __restrict__ W, int K, int N, int ND, bf16_t* WT, float* scr, int item, int lane) {
    const int nblk = ND / 64, kb = item / nblk, nb = item % nblk, k0 = 64 * kb, n0 = 64 * nb;
    const int c4 = (lane & 15) * 4, r4 = lane >> 4;
    int src = n0 + c4; if (MAP) src = inproj_src(src);
    f32x4 v[16];
#pragma unroll
    for (int i = 0; i < 16; ++i) v[i] = (src >= 0) ? *(const f32x4*)(W + (size_t)(k0 + 4 * i + r4) * N + src) : (f32x4){0.f, 0.f, 0.f, 0.f};
#pragma unroll
    for (int i = 0; i < 16; ++i) { float* d = scr + (4 * i + r4) * 65 + c4; d[0] = v[i][0]; d[1] = v[i][1]; d[2] = v[i][2]; d[3] = v[i][3]; }
    LDS_WAIT();
    const int c = lane & 7;
#pragma unroll
    for (int j = 0; j < 8; ++j) { const int n = (lane >> 3) + 8 * j; const float* s = scr + (8 * c) * 65 + n;
        u32x4 o; o.x = pk_bf16(s[0 * 65], s[1 * 65]); o.y = pk_bf16(s[2 * 65], s[3 * 65]); o.z = pk_bf16(s[4 * 65], s[5 * 65]); o.w = pk_bf16(s[6 * 65], s[7 * 65]);
        *(u32x4*)(WT + (size_t)(n0 + n) * K + k0 + 8 * c) = o; }
    LDS_WAIT();
}
__device__ __forceinline__ void rms_row_to_bf16(const float* __restrict__ xrow, const float* __restrict__ w, bf16_t* orow, int lane) {
    const f32x4* xr = (const f32x4*)xrow + lane; const f32x4* wr = (const f32x4*)w + lane;
    f32x4 v[8]; float s = 0.f;
#pragma unroll
    for (int j = 0; j < 8; ++j) { v[j] = xr[64 * j]; s += (v[j].x * v[j].x + v[j].y * v[j].y) + (v[j].z * v[j].z + v[j].w * v[j].w); }
    const float rstd = 1.0f / sqrtf(wave_sum(s) * (1.0f / 2048.0f) + 1e-6f);
    u32x2* o8 = (u32x2*)orow + lane;
#pragma unroll
    for (int j = 0; j < 8; ++j) { const f32x4 wv = wr[64 * j]; u32x2 o; o.x = pk_bf16(v[j].x * rstd * wv.x, v[j].y * rstd * wv.y); o.y = pk_bf16(v[j].z * rstd * wv.z, v[j].w * rstd * wv.w); o8[64 * j] = o; }
}
__device__ __forceinline__ void conv4_silu8(const bf16_t* __restrict__ U, int t, int ch, const float* __restrict__ cw, const float* __restrict__ cb, f32x4& o0, f32x4& o1) {
    f32x4 a0 = *(const f32x4*)(cb + ch), a1 = *(const f32x4*)(cb + ch + 4);
#pragma unroll
    for (int k = 0; k < 4; ++k) { const int tt = t - 3 + k;
        if (tt >= 0) { const u32x4 v = *(const u32x4*)(U + (size_t)tt * UP + 3072 + ch); const f32x4 w0 = *(const f32x4*)(cw + k * 1536 + ch), w1 = *(const f32x4*)(cw + k * 1536 + ch + 4);
            a0[0] += w0[0] * bf_lo(v.x); a0[1] += w0[1] * bf_hi(v.x); a0[2] += w0[2] * bf_lo(v.y); a0[3] += w0[3] * bf_hi(v.y);
            a1[0] += w1[0] * bf_lo(v.z); a1[1] += w1[1] * bf_hi(v.z); a1[2] += w1[2] * bf_lo(v.w); a1[3] += w1[3] * bf_hi(v.w); } }
#pragma unroll
    for (int i = 0; i < 4; ++i) { a0[i] = a0[i] / (1.0f + __expf(-a0[i])); a1[i] = a1[i] / (1.0f + __expf(-a1[i])); }
    o0 = a0; o1 = a1;
}
__device__ __forceinline__ int crow(int r, int hi) { return (r & 3) + 8 * (r >> 2) + 4 * hi; }

constexpr int AT_K = 0, AT_V = 18432, AT_C = 36864;
__device__ __forceinline__ void fox_unit(unsigned char* lds, const bf16_t* __restrict__ U, const bf16_t* __restrict__ Vt, const float* __restrict__ CL, bf16_t* YC, int h, int qb) {
    const int tid = threadIdx.x, lane = tid & 63, r32 = lane & 31, hi = lane >> 5; const int wid = __builtin_amdgcn_readfirstlane(tid >> 6);
    const int q0 = qb * 256, qrow = q0 + wid * 32 + r32, qfirst = q0 + wid * 32;
    bf16x8 qr[4];
#pragma unroll
    for (int d0 = 0; d0 < 4; ++d0) qr[d0] = *(const bf16x8*)(U + (size_t)qrow * UP + h * 64 + d0 * 16 + hi * 8);
    const float cq = CL[h * SEQ + qrow];
    const int NT = 4 * (qb + 1);
    const int lrow = tid >> 3, lck = tid & 7;
    const bf16_t* ksrc = U + (size_t)lrow * UP + 1024 + h * 64 + lck * 8;
    const bf16_t* vsrc = Vt + (size_t)(h * 64 + lrow) * SEQ + lck * 8;
    const float* csrc = CL + h * SEQ + (tid & 15) * 4;
    const int ldoff = (lrow * 72 + lck * 8) * 2;
    u32x4 kreg, vreg; f32x4 creg = {0.f, 0.f, 0.f, 0.f};
    kreg = *(const u32x4*)ksrc; vreg = *(const u32x4*)vsrc; if (tid < 16) creg = *(const f32x4*)csrc;
    *(u32x4*)(lds + AT_K + ldoff) = kreg; *(u32x4*)(lds + AT_V + ldoff) = vreg; if (tid < 16) *(f32x4*)(lds + AT_C + tid * 16) = creg;
    __syncthreads();
    float mrun = -INFINITY, lrun = 0.f;
    f32x16 o0 = {}, o1 = {};
    for (int t = 0; t < NT; ++t) {
        const int cur = t & 1;
        if (t + 1 < NT) { kreg = *(const u32x4*)(ksrc + (size_t)(t + 1) * 64 * UP); vreg = *(const u32x4*)(vsrc + (t + 1) * 64); if (tid < 16) creg = *(const f32x4*)(csrc + (t + 1) * 64); }
        if (64 * t <= qfirst + 31) {
            const unsigned char* Kb = lds + AT_K + cur * 9216; const unsigned char* Vb = lds + AT_V + cur * 9216; const float* Cb = (const float*)(lds + AT_C + cur * 256);
            f32x16 p0, p1;
#pragma unroll
            for (int g = 0; g < 4; ++g) { const f32x4 c0 = *(const f32x4*)(Cb + 8 * g + 4 * hi), c1 = *(const f32x4*)(Cb + 32 + 8 * g + 4 * hi);
#pragma unroll
                for (int i = 0; i < 4; ++i) { p0[4 * g + i] = cq - c0[i]; p1[4 * g + i] = cq - c1[i]; } }
#pragma unroll
            for (int d0 = 0; d0 < 4; ++d0) {
                const bf16x8 a0 = *(const bf16x8*)(Kb + (r32 * 72 + d0 * 16 + hi * 8) * 2);
                const bf16x8 a1 = *(const bf16x8*)(Kb + ((32 + r32) * 72 + d0 * 16 + hi * 8) * 2);
                p0 = __builtin_amdgcn_mfma_f32_32x32x16_bf16(a0, qr[d0], p0, 0, 0, 0);
                p1 = __builtin_amdgcn_mfma_f32_32x32x16_bf16(a1, qr[d0], p1, 0, 0, 0);
            }
            if (64 * t + 63 > qfirst) {
#pragma unroll
                for (int r = 0; r < 16; ++r) { const int kv = 64 * t + crow(r, hi); if (kv > qrow) p0[r] = -INFINITY; if (kv + 32 > qrow) p1[r] = -INFINITY; }
            }
            float rm = fmaxf(p0[0], p1[0]);
#pragma unroll
            for (int r = 1; r < 16; ++r) rm = fmaxf(rm, fmaxf(p0[r], p1[r]));
            rm = fmaxf(rm, __shfl_xor(rm, 32));
            const float mnew = fmaxf(mrun, rm); const float alpha = __builtin_amdgcn_exp2f(mrun - mnew); mrun = mnew;
            float ls = 0.f;
#pragma unroll
            for (int r = 0; r < 16; ++r) { p0[r] = __builtin_amdgcn_exp2f(p0[r] - mnew); p1[r] = __builtin_amdgcn_exp2f(p1[r] - mnew); ls += p0[r] + p1[r]; }
            lrun = lrun * alpha + ls;
#pragma unroll
            for (int r = 0; r < 16; ++r) { o0[r] *= alpha; o1[r] *= alpha; }
#pragma unroll
            for (int b = 0; b < 2; ++b)
#pragma unroll
                for (int s = 0; s < 2; ++s) {
                    u32x4 pw;
                    if (b == 0) { pw.x = pk_bf16(p0[8 * s + 0], p0[8 * s + 1]); pw.y = pk_bf16(p0[8 * s + 2], p0[8 * s + 3]); pw.z = pk_bf16(p0[8 * s + 4], p0[8 * s + 5]); pw.w = pk_bf16(p0[8 * s + 6], p0[8 * s + 7]); }
                    else        { pw.x = pk_bf16(p1[8 * s + 0], p1[8 * s + 1]); pw.y = pk_bf16(p1[8 * s + 2], p1[8 * s + 3]); pw.z = pk_bf16(p1[8 * s + 4], p1[8 * s + 5]); pw.w = pk_bf16(p1[8 * s + 6], p1[8 * s + 7]); }
                    const bf16x8 pb = __builtin_bit_cast(bf16x8, pw);
                    const int kvo = 32 * b + 16 * s + 4 * hi;
                    {   const u32x2 v0 = *(const u32x2*)(Vb + (r32 * 72 + kvo) * 2), v1 = *(const u32x2*)(Vb + (r32 * 72 + kvo + 8) * 2);
                        const u32x4 vv = {v0.x, v0.y, v1.x, v1.y}; o0 = __builtin_amdgcn_mfma_f32_32x32x16_bf16(__builtin_bit_cast(bf16x8, vv), pb, o0, 0, 0, 0); }
                    {   const u32x2 v0 = *(const u32x2*)(Vb + ((32 + r32) * 72 + kvo) * 2), v1 = *(const u32x2*)(Vb + ((32 + r32) * 72 + kvo + 8) * 2);
                        const u32x4 vv = {v0.x, v0.y, v1.x, v1.y}; o1 = __builtin_amdgcn_mfma_f32_32x32x16_bf16(__builtin_bit_cast(bf16x8, vv), pb, o1, 0, 0, 0); }
                }
        }
        if (t + 1 < NT) { const int nb = (cur ^ 1); *(u32x4*)(lds + AT_K + nb * 9216 + ldoff) = kreg; *(u32x4*)(lds + AT_V + nb * 9216 + ldoff) = vreg; if (tid < 16) *(f32x4*)(lds + AT_C + nb * 256 + tid * 16) = creg; }
        __syncthreads();
    }
    lrun += __shfl_xor(lrun, 32);
    const float inv = 1.0f / lrun;
    bf16_t* orow = YC + (size_t)qrow * 2048 + h * 64 + 4 * hi;
#pragma unroll
    for (int g = 0; g < 4; ++g) {
        u32x2 w0, w1;
        w0.x = pk_bf16(o0[4 * g] * inv, o0[4 * g + 1] * inv); w0.y = pk_bf16(o0[4 * g + 2] * inv, o0[4 * g + 3] * inv);
        w1.x = pk_bf16(o1[4 * g] * inv, o1[4 * g + 1] * inv); w1.y = pk_bf16(o1[4 * g + 2] * inv, o1[4 * g + 3] * inv);
        *(u32x2*)(orow + 8 * g) = w0; *(u32x2*)(orow + 32 + 8 * g) = w1;
    }
}
#define XB_TMO      128
#define XB_XCNT(j)  (256  + 64 * (j))
#define XB_XSUB(j)  (1280 + 64 * (j))
#define XB_XGEN(j)  (2304 + 64 * (j))
#define XB_TOP      3328
#define XB_TOPGEN   3392
#define XCD_BAR_WORDS 3456
#define XB_SPIN_CAP (1u << 18)

__device__ __forceinline__ unsigned xb_ld(unsigned* p)              { return __hip_atomic_load(p, __ATOMIC_RELAXED, __HIP_MEMORY_SCOPE_AGENT); }
__device__ __forceinline__ unsigned xb_add(unsigned* p, unsigned v) { return __hip_atomic_fetch_add(p, v, __ATOMIC_RELAXED, __HIP_MEMORY_SCOPE_AGENT); }
__device__ __forceinline__ unsigned xb_xcc_id() { return (unsigned)__builtin_amdgcn_s_getreg((3 << 11) | 20) & 0xFu; }
#define XB_SPIN(cond, bar) do { unsigned _sp = 0; while (cond) { __builtin_amdgcn_s_sleep(1); \
    if ((++_sp & 255u) == 0u) { if (xb_ld(&(bar)[XB_TMO])) break; if (_sp > XB_SPIN_CAP) { atomicAdd(&(bar)[XB_TMO], 1u); break; } } } } while (0)

struct XcdBarrier {
    unsigned* bar; unsigned x;
    volatile LAS unsigned* st;
};

__device__ __forceinline__ XcdBarrier xcd_barrier_post(unsigned* bar, volatile LAS unsigned* st) {
    XcdBarrier b; b.bar = bar; b.x = xb_xcc_id(); b.st = st;
    if (threadIdx.x == 0) (void)xb_add(&bar[XB_XCNT(b.x)], 1u);
    return b;
}
__device__ __forceinline__ void xcd_barrier_complete(unsigned* bar, unsigned x, unsigned& nloc, unsigned& nx) {
    const unsigned G = gridDim.x * gridDim.y * gridDim.z;
    unsigned sum, cnt, mine, sp = 0u;
    for (;;) {
        sum = 0u; cnt = 0u; mine = 0u;
#pragma unroll
        for (unsigned j = 0; j < 16; ++j) { const unsigned c = xb_ld(&bar[XB_XCNT(j)]); sum += c; cnt += (c > 0u) ? 1u : 0u; mine = (j == x) ? c : mine; }
        if (sum == G) break;
        __builtin_amdgcn_s_sleep(1);
        if ((++sp & 255u) == 0u) { if (xb_ld(&bar[XB_TMO])) break; if (sp > XB_SPIN_CAP) { atomicAdd(&bar[XB_TMO], 1u); break; } }
    }
    nloc = mine > 0u ? mine : 1u; nx = cnt > 0u ? cnt : 1u;
}

__device__ __forceinline__ void xcd_barrier(const XcdBarrier& b) {
    asm volatile("s_waitcnt vmcnt(0)" ::: "memory");
    __syncthreads();
    if (threadIdx.x == 0) {
        unsigned* bar = b.bar;
        __builtin_amdgcn_s_waitcnt(0);
        unsigned nloc = b.st[0], nx = b.st[1];
        if (nloc == 0u) { xcd_barrier_complete(bar, b.x, nloc, nx); b.st[0] = nloc; b.st[1] = nx; }
        const unsigned old = xb_add(&bar[XB_XSUB(b.x)], 1u);
        const unsigned gen = old / nloc;
        if (old + 1u == (gen + 1u) * nloc) {
            __builtin_amdgcn_fence(__ATOMIC_RELEASE, "agent");
            asm volatile("s_waitcnt vmcnt(0)" ::: "memory");
            const unsigned og = xb_add(&bar[XB_TOP], 1u);
            const unsigned tg = og / nx;
            if (og + 1u == (tg + 1u) * nx) xb_add(&bar[XB_TOPGEN], 1u);
            else XB_SPIN(xb_ld(&bar[XB_TOPGEN]) == tg, bar);
            __builtin_amdgcn_fence(__ATOMIC_ACQUIRE, "agent");
            xb_add(&bar[XB_XGEN(b.x)], 1u);
            asm volatile("s_waitcnt vmcnt(0)" ::: "memory");
        } else {
            XB_SPIN(xb_ld(&bar[XB_XGEN(b.x)]) == gen, bar);
            __builtin_amdgcn_fence(__ATOMIC_ACQUIRE, "agent");
            asm volatile("s_waitcnt vmcnt(0)" ::: "memory");
        }
    }
    __syncthreads();
}

constexpr int SL_XT = 0;
constexpr int SL_CM = 73728;
constexpr int SL_BM = 91136;
constexpr int SL_GG = 108544;
constexpr int SL_DT = 125952, SL_AC = 128000, SL_SW = 130048;

#ifndef PHMASK
#define PHMASK 0xFFFF
#endif
#define PH(n) ((PHMASK >> (n)) & 1)
struct Params { const float* in[21]; float* out; unsigned char* ws; };

__device__ __forceinline__ void ssd_stage_xt_dt(unsigned char* lds, const bf16_t* U, const float* AUX, const float* cw, const float* cb, float dtb, float Ah, int t0, int h, int wave, int lane, float& dt_out, float& ac_out) {
    bf16_t* XT = (bf16_t*)(lds + SL_XT + wave * 9216);
#pragma unroll 2
    for (int it = 0; it < 8; ++it) { const int idx = it * 64 + lane, s = idx >> 3, ck = idx & 7; f32x4 a0, a1; conv4_silu8(U, t0 + s, h * 64 + ck * 8, cw, cb, a0, a1);
#pragma unroll
        for (int i = 0; i < 4; ++i) { XT[(ck * 8 + i) * 72 + s] = f2bf(a0[i]); XT[(ck * 8 + 4 + i) * 72 + s] = f2bf(a1[i]); } }
    const float xr = AUX[(size_t)(t0 + lane) * 32 + 16 + h] + dtb;
    const float dt = (xr > 20.f) ? xr : log1pf(expf(xr));
    float ac = dt * Ah;
#pragma unroll
    for (int o = 1; o < 64; o <<= 1) { const float n = __shfl_up(ac, o); if (lane >= o) ac += n; }
    dt_out = dt; ac_out = ac;
}

__global__ void __launch_bounds__(NTHREADS, 2) fwd_megakernel(Params P) {
    extern __shared__ __attribute__((aligned(16))) unsigned char lds[];
    cg::grid_group grid = cg::this_grid();
    const int G = gridDim.x, bid = blockIdx.x, nthr = G * NTHREADS;
#define TVARS int tid = threadIdx.x; asm volatile("" : "+v"(tid)); const int lane = tid & 63, wave = __builtin_amdgcn_readfirstlane(tid >> 6), quad = lane >> 4, l15 = lane & 15, gtid = bid * NTHREADS + tid; (void)quad; (void)l15; (void)gtid; (void)wave; (void)lane;
    unsigned char* ws = P.ws;
    const float* x = P.in[0]; float* out = P.out;
    float* RS1 = (float*)(ws + WS_RS1); float* RS2 = (float*)(ws + WS_RS2); float* RS3 = (float*)(ws + WS_RS3); float* RSS = (float*)(ws + WS_RSS);
    float* CD = (float*)(ws + WS_CD); float* CL = (float*)(ws + WS_CL); float* AUX = (float*)(ws + WS_AUX);
    bf16_t* Wgu_t = (bf16_t*)(ws + WS_WGU); bf16_t* Wd_t = (bf16_t*)(ws + WS_WD); bf16_t* Wpg_t = (bf16_t*)(ws + WS_WPG); bf16_t* Wpp_t = (bf16_t*)(ws + WS_WPP);
    bf16_t* XW = (bf16_t*)(ws + WS_XW); bf16_t* PP = (bf16_t*)(ws + WS_PP); bf16_t* Win_t = (bf16_t*)(ws + WS_WIN); bf16_t* Wout_t = (bf16_t*)(ws + WS_WOUT);
    bf16_t* P16 = (bf16_t*)(ws + WS_P16); bf16_t* U = (bf16_t*)(ws + WS_U); bf16_t* Vt = (bf16_t*)(ws + WS_VT); bf16_t* ST = (bf16_t*)(ws + WS_ST);
    bf16_t* YC = (bf16_t*)(ws + WS_YC); bf16_t* GU = (bf16_t*)(ws + WS_GU);
    __attribute__((address_space(3))) unsigned char* glds = (__attribute__((address_space(3))) unsigned char*)lds;
    if (threadIdx.x < 16) ((volatile LAS unsigned*)(glds + LDS_BYTES - 64))[threadIdx.x] = 0u;
    __syncthreads();
    const XcdBarrier xbar = xcd_barrier_post((unsigned*)(ws + WS_BAR), (volatile LAS unsigned*)(glds + LDS_BYTES - 64));
#define GRID_BAR() xcd_barrier(xbar)

#ifndef REP_P0
#define REP_P0 1
#endif
#ifndef REP_P2
#define REP_P2 1
#endif
#ifndef EXTRA_SYNCS
#define EXTRA_SYNCS 0
#endif
    for (int rep0 = 0; rep0 < REP_P0; ++rep0) if (PH(0)) { TVARS
        float* scr = (float*)(lds + wave * 16640);
        const int gw = bid * 8 + wave, NGW = G * 8;
        constexpr int I_IN = 32 * 92, I_OUT = 32 * 32, I_GU = 32 * 176, I_D = 88 * 32, I_PG = 32 * 32, I_PP = 4 * 32;
        constexpr int NITEMS = I_IN + I_OUT + I_GU + I_D + I_PG + I_PP;
        for (int it = gw; it < NITEMS; it += NGW) {
            int r = it;
            if (r < I_IN) { transpose_item<true>(P.in[3], 2048, 5664, NIN, Win_t, scr, r, lane); continue; } r -= I_IN;
            if (r < I_OUT) { transpose_item<false>(P.in[11], 2048, 2048, 2048, Wout_t, scr, r, lane); continue; } r -= I_OUT;
            if (r < I_GU) { transpose_item<false>(P.in[13], 2048, GUP, GUP, Wgu_t, scr, r, lane); continue; } r -= I_GU;
            if (r < I_D) { transpose_item<false>(P.in[16], DFF, 2048, 2048, Wd_t, scr, r, lane); continue; } r -= I_D;
            if (r < I_PG) { transpose_item<false>(P.in[18], 2048, 2048, 2048, Wpg_t, scr, r, lane); continue; } r -= I_PG;
            transpose_item<false>(P.in[19], 256, 2048, 2048, Wpp_t, scr, r, lane);
        }
        for (int m = gw; m < SEQ; m += NGW) rms_row_to_bf16(x + (size_t)m * DM, P.in[2], XW + (size_t)m * DM, lane);
        const float* pin = P.in[1];
        for (int i = gtid; i < SEQ * 256 / 8; i += nthr) { const f32x4 a = *(const f32x4*)(pin + (size_t)i * 8), b = *(const f32x4*)(pin + (size_t)i * 8 + 4); *(u32x4*)(P16 + (size_t)i * 8) = pk8(a, b); }
        for (int i = gtid; i < 4 * SEQ; i += nthr) RS1[i] = 0.f;
    }
    if (P.ws == nullptr) grid.sync();
    GRID_BAR();

    if (PH(1)) {
        pg8::Gemm g{XW, Win_t, SEQ, NIN, DM, DM}; pg8::StaticOrder S; S.init(SEQ, NIN, G, bid);
        pg8::EpiInProj E{U, AUX, QSCALE};
        pg8::gemm_phase<pg8::EpiInProj, pg8::StaticOrder, true, true>(glds, g, S, E);
    }
    if (PH(13)) {
        int kpp = 256; asm volatile("" : "+s"(kpp));
        pg8::Gemm g{P16, Wpp_t, SEQ, DM, kpp, kpp}; pg8::StaticOrder S; S.init(SEQ, DM, G, bid);
        pg8::EpiPlainBf16 E{PP, DM};
        pg8::gemm_phase<pg8::EpiPlainBf16, pg8::StaticOrder, true, true>(glds, g, S, E);
    }
    GRID_BAR();

    for (int i = 0; i < EXTRA_SYNCS; ++i) GRID_BAR();
    for (int rep2 = 0; rep2 < REP_P2; ++rep2) {
    if (PH(2)) for (int h = bid; h < 16; h += G) { TVARS
        float* wsum = (float*)(lds + 140000);
        const float bfh = P.in[4][h]; const int t0 = tid * 16;
        float run = 0.f; float loc[16];
#pragma unroll
        for (int i = 0; i < 16; ++i) { const float xv = AUX[(size_t)(t0 + i) * 32 + h] + bfh; const float ls = fminf(xv, 0.f) - log1pf(expf(-fabsf(xv))); run += ls; loc[i] = run; }
        float incl = run;
#pragma unroll
        for (int o = 1; o < 64; o <<= 1) { const float n = __shfl_up(incl, o); if (lane >= o) incl += n; }
        if (lane == 63) wsum[wave] = incl;
        __syncthreads();
        float pre = 0.f;
#pragma unroll
        for (int w = 0; w < 8; ++w) { const float v = wsum[w]; if (w < wave) pre += v; }
        const float excl = pre + incl - run;
#pragma unroll
        for (int i = 0; i < 16; ++i) CL[h * SEQ + t0 + i] = (excl + loc[i]) * LOG2E;
        __syncthreads();
    }
    if (PH(2)) for (int it = bid; it < 2048; it += G) { TVARS
        const int h = it >> 7, tb = it & 127; bf16_t* tileT = (bf16_t*)(lds + 4096);
        const int row = tid >> 3, ck = tid & 7;
        const u32x4 v = *(const u32x4*)(U + (size_t)(tb * 64 + row) * UP + 2048 + h * 64 + ck * 8);
        tileT[(ck * 8 + 0) * 72 + row] = (bf16_t)(v.x & 0xffff); tileT[(ck * 8 + 1) * 72 + row] = (bf16_t)(v.x >> 16);
        tileT[(ck * 8 + 2) * 72 + row] = (bf16_t)(v.y & 0xffff); tileT[(ck * 8 + 3) * 72 + row] = (bf16_t)(v.y >> 16);
        tileT[(ck * 8 + 4) * 72 + row] = (bf16_t)(v.z & 0xffff); tileT[(ck * 8 + 5) * 72 + row] = (bf16_t)(v.z >> 16);
        tileT[(ck * 8 + 6) * 72 + row] = (bf16_t)(v.w & 0xffff); tileT[(ck * 8 + 7) * 72 + row] = (bf16_t)(v.w >> 16);
        __syncthreads();
        const u32x4 o = *(const u32x4*)(tileT + row * 72 + ck * 8);
        *(u32x4*)(Vt + (size_t)(h * 64 + row) * SEQ + tb * 64 + ck * 8) = o;
        __syncthreads();
    }
    if (PH(2)) { TVARS
        const float* cw = P.in[5]; const float* cb = P.in[6];
        for (int it = bid; it < 256; it += G) {
            const int c = it >> 1, g = it & 1, t0 = c * 64, h = g * 8 + wave;
            bf16_t* BMT = (bf16_t*)(lds + SL_CM);
            for (int idx = tid; idx < 1024; idx += NTHREADS) { const int s = idx >> 4, ck = idx & 15; f32x4 a0, a1; conv4_silu8(U, t0 + s, 1024 + g * 128 + ck * 8, cw, cb, a0, a1);
#pragma unroll
                for (int i = 0; i < 4; ++i) { BMT[(ck * 8 + i) * 72 + s] = f2bf(a0[i]); BMT[(ck * 8 + 4 + i) * 72 + s] = f2bf(a1[i]); } }
            float dt, ac; const float Ah = -expf(P.in[8][h]);
            ssd_stage_xt_dt(lds, U, AUX, cw, cb, P.in[7][h], Ah, t0, h, wave, lane, dt, ac);
            const float ac63 = __shfl(ac, 63);
            float* SW = (float*)(lds + SL_SW + wave * 256);
            SW[lane] = expf(ac63 - ac) * dt;
            if (lane == 0) CD[c * 16 + h] = expf(ac63);
            __syncthreads();
            const bf16_t* XT = (const bf16_t*)(lds + SL_XT + wave * 9216);
            for (int pt = 0; pt < 4; ++pt) {
                bf16x8 af[2];
#pragma unroll
                for (int ks = 0; ks < 2; ++ks) { const bf16x8 xa = *(const bf16x8*)(XT + (pt * 16 + l15) * 72 + ks * 32 + quad * 8);
                    const f32x4 w0 = *(const f32x4*)(SW + ks * 32 + quad * 8), w1 = *(const f32x4*)(SW + ks * 32 + quad * 8 + 4);
                    u32x4 pw; pw.x = pk_bf16(s2f(xa[0]) * w0[0], s2f(xa[1]) * w0[1]); pw.y = pk_bf16(s2f(xa[2]) * w0[2], s2f(xa[3]) * w0[3]);
                    pw.z = pk_bf16(s2f(xa[4]) * w1[0], s2f(xa[5]) * w1[1]); pw.w = pk_bf16(s2f(xa[6]) * w1[2], s2f(xa[7]) * w1[3]);
                    af[ks] = __builtin_bit_cast(bf16x8, pw); }
                f32x4 acc[8];
#pragma unroll
                for (int nt = 0; nt < 8; ++nt) { acc[nt] = (f32x4){0.f, 0.f, 0.f, 0.f};
#pragma unroll
                    for (int ks = 0; ks < 2; ++ks) { const bf16x8 b = *(const bf16x8*)(BMT + (nt * 16 + l15) * 72 + ks * 32 + quad * 8);
                        acc[nt] = __builtin_amdgcn_mfma_f32_16x16x32_bf16(af[ks], b, acc[nt], 0, 0, 0); } }
#pragma unroll
                for (int nt = 0; nt < 8; ++nt)
#pragma unroll
                    for (int r = 0; r < 4; ++r) ST[((size_t)(c * 16 + h) * 64 + pt * 16 + quad * 4 + r) * 128 + nt * 16 + l15] = f2bf(acc[nt][r]);
            }
            __syncthreads();
        }
    }
    }
    GRID_BAR();

#ifndef REP_P3
#define REP_P3 1
#endif
#ifndef REP_S3
#define REP_S3 1
#endif
    if (PH(3)) for (int rep3 = 0; rep3 < REP_P3; ++rep3) { TVARS bf16_t* STD = (rep3 + 1 < REP_P3) ? (bf16_t*)out : ST; for (int e = gtid; e < 131072; e += nthr) {
        const int h = e >> 13; float run = 0.f;
        for (int c0 = 0; c0 < 128; c0 += 8) {
            float sv[8], dv[8];
#pragma unroll
            for (int j = 0; j < 8; ++j) { sv[j] = bf2f(ST[(size_t)(c0 + j) * 131072 + e]); dv[j] = CD[(c0 + j) * 16 + h]; }
#pragma unroll
            for (int j = 0; j < 8; ++j) { STD[(size_t)(c0 + j) * 131072 + e] = f2bf(run); run = run * dv[j] + sv[j]; }
        }
    } }
    GRID_BAR();

    { TVARS
        const float* cw = P.in[5]; const float* cb = P.in[6]; const float* nw = P.in[10];
        for (int reps = 0; reps < REP_S3; ++reps) { bf16_t* YCD = (reps + 1 < REP_S3) ? (bf16_t*)out : YC; float* RSD = (reps + 1 < REP_S3) ? (out + 12 * 1024 * 1024) : RSS;
        if (PH(4)) for (int it = bid; it < 256; it += G) {
            const int c = it >> 1, g = it & 1, t0 = c * 64, h = g * 8 + wave;
            bf16_t* CM = (bf16_t*)(lds + SL_CM); bf16_t* BM = (bf16_t*)(lds + SL_BM); float* GG = (float*)(lds + SL_GG);
            for (int idx = tid; idx < 2048; idx += NTHREADS) { const int which = idx >> 10, s = (idx >> 4) & 63, ck = idx & 15; f32x4 a0, a1;
                conv4_silu8(U, t0 + s, 1024 + which * 256 + g * 128 + ck * 8, cw, cb, a0, a1);
                *(u32x4*)((which ? CM : BM) + s * 136 + ck * 8) = pk8(a0, a1); }
            float dt, ac; const float Ah = -expf(P.in[8][h]);
            ssd_stage_xt_dt(lds, U, AUX, cw, cb, P.in[7][h], Ah, t0, h, wave, lane, dt, ac);
            float* SDT = (float*)(lds + SL_DT + wave * 256); float* SAC = (float*)(lds + SL_AC + wave * 256);
            SDT[lane] = dt; SAC[lane] = ac;
            __syncthreads();
#pragma unroll
            for (int k2 = 0; k2 < 2; ++k2) { const int id = 2 * wave + k2, lt = id >> 2, st = id & 3; f32x4 acc = {0.f, 0.f, 0.f, 0.f};
#pragma unroll
                for (int ks = 0; ks < 4; ++ks) { const bf16x8 a = *(const bf16x8*)(CM + (lt * 16 + l15) * 136 + ks * 32 + quad * 8), b = *(const bf16x8*)(BM + (st * 16 + l15) * 136 + ks * 32 + quad * 8);
                    acc = __builtin_amdgcn_mfma_f32_16x16x32_bf16(a, b, acc, 0, 0, 0); }
#pragma unroll
                for (int r = 0; r < 4; ++r) GG[(lt * 16 + quad * 4 + r) * 68 + st * 16 + l15] = acc[r]; }
            __syncthreads();
            const bf16_t* XT = (const bf16_t*)(lds + SL_XT + wave * 9216);
            const float Dh = P.in[9][h];
            const bf16_t* HP = ST + (size_t)(c * 16 + h) * 64 * 128;
            for (int lt = 0; lt < 4; ++lt) {
                const int la = lt * 16 + l15; const float acl = SAC[la];
                f32x4 yd[4], yo[4];
#pragma unroll
                for (int pt = 0; pt < 4; ++pt) { yd[pt] = (f32x4){0.f, 0.f, 0.f, 0.f}; yo[pt] = (f32x4){0.f, 0.f, 0.f, 0.f}; }
#pragma unroll
                for (int ks = 0; ks < 2; ++ks) {
                    if (ks * 32 <= lt * 16 + 15) {
                        const int s0 = ks * 32 + quad * 8;
                        const f32x4 g0 = *(const f32x4*)(GG + la * 68 + s0), g1 = *(const f32x4*)(GG + la * 68 + s0 + 4);
                        const f32x4 e0 = *(const f32x4*)(SAC + s0), e1 = *(const f32x4*)(SAC + s0 + 4), d0 = *(const f32x4*)(SDT + s0), d1 = *(const f32x4*)(SDT + s0 + 4);
                        float mv[8];
#pragma unroll
                        for (int j = 0; j < 4; ++j) { mv[j] = (s0 + j <= la) ? g0[j] * __expf(fminf(acl - e0[j], 0.f)) * d0[j] : 0.f; mv[4 + j] = (s0 + 4 + j <= la) ? g1[j] * __expf(fminf(acl - e1[j], 0.f)) * d1[j] : 0.f; }
                        u32x4 pw; pw.x = pk_bf16(mv[0], mv[1]); pw.y = pk_bf16(mv[2], mv[3]); pw.z = pk_bf16(mv[4], mv[5]); pw.w = pk_bf16(mv[6], mv[7]);
                        const bf16x8 a = __builtin_bit_cast(bf16x8, pw);
#pragma unroll
                        for (int pt = 0; pt < 4; ++pt) { const bf16x8 b = *(const bf16x8*)(XT + (pt * 16 + l15) * 72 + s0); yd[pt] = __builtin_amdgcn_mfma_f32_16x16x32_bf16(a, b, yd[pt], 0, 0, 0); }
                    }
                }
#pragma unroll
                for (int ks = 0; ks < 4; ++ks) { const bf16x8 a = *(const bf16x8*)(CM + la * 136 + ks * 32 + quad * 8);
#pragma unroll
                    for (int pt = 0; pt < 4; ++pt) { const bf16x8 b = *(const bf16x8*)(HP + (size_t)(pt * 16 + l15) * 128 + ks * 32 + quad * 8); yo[pt] = __builtin_amdgcn_mfma_f32_16x16x32_bf16(a, b, yo[pt], 0, 0, 0); } }
                const int lc = lt * 16 + quad * 4;
                const f32x4 eav = *(const f32x4*)(SAC + lc);
                float ea[4], rsum[4];
#pragma unroll
                for (int r = 0; r < 4; ++r) { ea[r] = __expf(eav[r]); rsum[r] = 0.f; }
#pragma unroll
                for (int pt = 0; pt < 4; ++pt) { const int p = pt * 16 + l15; const u32x2 xw = *(const u32x2*)(XT + p * 72 + lc);
                    const float xv[4] = {bf_lo(xw.x), bf_hi(xw.x), bf_lo(xw.y), bf_hi(xw.y)}; const float nwp = nw[h * 64 + p];
#pragma unroll
                    for (int r = 0; r < 4; ++r) { const int t = t0 + lc + r; float y = yd[pt][r] + ea[r] * yo[pt][r] + Dh * xv[r];
                        const float z = bf2f(U[(size_t)t * UP + 4608 + h * 64 + p]); y *= z / (1.0f + __expf(-z)); rsum[r] += y * y;
                        YCD[(size_t)t * 2048 + 1024 + h * 64 + p] = f2bf(y * nwp); } }
#pragma unroll
                for (int r = 0; r < 4; ++r) { float v = rsum[r]; v += __shfl_xor(v, 1); v += __shfl_xor(v, 2); v += __shfl_xor(v, 4); v += __shfl_xor(v, 8); if (l15 == 0) unsafeAtomicAdd(RSD + t0 + lc + r, v); }
            }
            __syncthreads();
        }
        }
#ifndef REP_ATT
#define REP_ATT 1
#endif
        if (PH(12)) for (int rep = 0; rep < REP_ATT; ++rep) for (int it = bid; it < 256; it += G) { const int h = it >> 4, s = it & 15;
            fox_unit(lds, U, Vt, CL, YC, h, 31 - s);
            fox_unit(lds, U, Vt, CL, YC, h, s); }
    }
    GRID_BAR();

    if (PH(5)) { TVARS for (int i = gtid; i < SEQ * 128; i += nthr) { const int row = i >> 7, ck = i & 127; const float rs = 1.0f / sqrtf(RSS[row] * (1.0f / 1024.0f) + 1e-6f);
        bf16_t* p = YC + (size_t)row * 2048 + 1024 + ck * 8; const u32x4 v = *(const u32x4*)p;
        u32x4 o; o.x = pk_bf16(bf_lo(v.x) * rs, bf_hi(v.x) * rs); o.y = pk_bf16(bf_lo(v.y) * rs, bf_hi(v.y) * rs); o.z = pk_bf16(bf_lo(v.z) * rs, bf_hi(v.z) * rs); o.w = pk_bf16(bf_lo(v.w) * rs, bf_hi(v.w) * rs);
        *(u32x4*)p = o; } }
    GRID_BAR();

    if (PH(6)) {
        pg8::Gemm g{YC, Wout_t, SEQ, DM, DM, DM}; pg8::StaticOrder S; S.init(SEQ, DM, G, bid);
        pg8::EpiRes<0> E{x, out, XW, P.in[12], RS1, nullptr, nullptr};
        pg8::gemm_phase<pg8::EpiRes<0>, pg8::StaticOrder, true, true>(glds, g, S, E);
    }
    GRID_BAR();

#ifndef REP_GU
#define REP_GU 1
#endif
    if (PH(7)) {
        pg8::Gemm g{XW, Wgu_t, SEQ, GUP, DM, DM}; pg8::StaticOrder S; S.init(SEQ, GUP, G, bid);
        pg8::EpiRowScaleBf16 E{GU, GUP, RS1};
        pg8::gemm_phase<pg8::EpiRowScaleBf16, pg8::StaticOrder, true, true>(glds, g, S, E);
    }
    GRID_BAR();

#if REP_GU > 1
    {
        pg8::Gemm g{XW, Wgu_t, SEQ, GUP, DM, DM}; pg8::StaticOrder S; S.init(SEQ, GUP, G, bid);
        pg8::EpiRowScaleBf16 E{GU, GUP, RS1};
        pg8::gemm_phase<pg8::EpiRowScaleBf16, pg8::StaticOrder, true, true>(glds, g, S, E);
    }
    GRID_BAR();
#endif
    if (PH(8)) { TVARS
        const float* fw = P.in[14]; const float* fb = P.in[15];
        for (int it = gtid; it < 704 * 256; it += nthr) {
            const int ck = it % 704, seg = it / 704, tb = seg * 32, col = ck * 8;
            f32x4 w0a = *(const f32x4*)(fw + col), w0b = *(const f32x4*)(fw + col + 4), w1a = *(const f32x4*)(fw + DFF + col), w1b = *(const f32x4*)(fw + DFF + col + 4);
            f32x4 w2a = *(const f32x4*)(fw + 2 * DFF + col), w2b = *(const f32x4*)(fw + 2 * DFF + col + 4), ba = *(const f32x4*)(fb + col), bb = *(const f32x4*)(fb + col + 4);
            u32x4 gm2 = {0u, 0u, 0u, 0u}, gm1 = {0u, 0u, 0u, 0u};
            if (tb > 0) { gm2 = *(const u32x4*)(GU + (size_t)(tb - 2) * GUP + col); gm1 = *(const u32x4*)(GU + (size_t)(tb - 1) * GUP + col); }
            for (int t8 = tb; t8 < tb + 32; t8 += 8) {
                u32x4 gv[8], uv[8];
#pragma unroll
                for (int j = 0; j < 8; ++j) { gv[j] = *(const u32x4*)(GU + (size_t)(t8 + j) * GUP + col); uv[j] = *(const u32x4*)(GU + (size_t)(t8 + j) * GUP + DFF + col); }
#pragma unroll
                for (int j = 0; j < 8; ++j) {
                    const u32x4 g0 = gv[j], uu = uv[j];
                    f32x4 va, vb;
                    va[0] = ba[0] + w0a[0] * bf_lo(gm2.x) + w1a[0] * bf_lo(gm1.x) + w2a[0] * bf_lo(g0.x); va[1] = ba[1] + w0a[1] * bf_hi(gm2.x) + w1a[1] * bf_hi(gm1.x) + w2a[1] * bf_hi(g0.x);
                    va[2] = ba[2] + w0a[2] * bf_lo(gm2.y) + w1a[2] * bf_lo(gm1.y) + w2a[2] * bf_lo(g0.y); va[3] = ba[3] + w0a[3] * bf_hi(gm2.y) + w1a[3] * bf_hi(gm1.y) + w2a[3] * bf_hi(g0.y);
                    vb[0] = bb[0] + w0b[0] * bf_lo(gm2.z) + w1b[0] * bf_lo(gm1.z) + w2b[0] * bf_lo(g0.z); vb[1] = bb[1] + w0b[1] * bf_hi(gm2.z) + w1b[1] * bf_hi(gm1.z) + w2b[1] * bf_hi(g0.z);
                    vb[2] = bb[2] + w0b[2] * bf_lo(gm2.w) + w1b[2] * bf_lo(gm1.w) + w2b[2] * bf_lo(g0.w); vb[3] = bb[3] + w0b[3] * bf_hi(gm2.w) + w1b[3] * bf_hi(gm1.w) + w2b[3] * bf_hi(g0.w);
                    const f32x4 ua = {bf_lo(uu.x), bf_hi(uu.x), bf_lo(uu.y), bf_hi(uu.y)}, ub = {bf_lo(uu.z), bf_hi(uu.z), bf_lo(uu.w), bf_hi(uu.w)};
#pragma unroll
                    for (int i = 0; i < 4; ++i) { va[i] = va[i] / (1.0f + __expf(-va[i])) * ua[i]; vb[i] = vb[i] / (1.0f + __expf(-vb[i])) * ub[i]; }
                    *(u32x4*)(GU + (size_t)(t8 + j) * GUP + DFF + col) = pk8(va, vb);
                    gm2 = gm1; gm1 = g0;
                }
            }
        }
    }
    GRID_BAR();

    if (PH(9)) {
        pg8::Gemm g{GU + DFF, Wd_t, SEQ, DM, DFF, GUP}; pg8::StaticOrder S; S.init(SEQ, DM, G, bid);
        pg8::EpiRes<1> E{out, out, XW, P.in[17], RS2, nullptr, nullptr};
        pg8::gemm_phase<pg8::EpiRes<1>, pg8::StaticOrder, true, true>(glds, g, S, E);
    }
    GRID_BAR();

    if (PH(10)) {
        pg8::Gemm g{XW, Wpg_t, SEQ, DM, DM, DM}; pg8::StaticOrder S; S.init(SEQ, DM, G, bid);
        pg8::EpiRes<2> E{out, out, nullptr, nullptr, RS3, RS2, PP};
        pg8::gemm_phase<pg8::EpiRes<2>, pg8::StaticOrder, true, true>(glds, g, S, E);
    }
    GRID_BAR();

    if (PH(11)) { TVARS
        const float* fnw = P.in[20];
        for (int i = gtid; i < SEQ * 512; i += nthr) { const int row = i >> 9, c4 = i & 511; const float rs = 1.0f / sqrtf(RS3[row] * (1.0f / 2048.0f) + 1e-6f);
            f32x4* p = (f32x4*)(out + (size_t)row * DM) + c4; const f32x4 w = ((const f32x4*)fnw)[c4]; *p = (*p) * rs * w; }
    }
}

extern "C" void kernel_launch(void* const* d_in, const int* in_sizes, int n_in, void* d_out, int out_size, void* d_ws, size_t ws_size, hipStream_t stream) {
    static int grid = 0;
    if (grid == 0) {
        if (n_in != 21 || out_size != SEQ * DM || ws_size < WS_END) { fprintf(stderr, "kernel_launch: unexpected problem (n_in %d, out %d, ws %zu)\n", n_in, out_size, ws_size); grid = -1; return; }
        int dev = 0, cus = 0, per_cu = 0;
        hipGetDevice(&dev); hipDeviceGetAttribute(&cus, hipDeviceAttributeMultiprocessorCount, dev);
        hipFuncSetAttribute((const void*)fwd_megakernel, hipFuncAttributeMaxDynamicSharedMemorySize, LDS_BYTES);
        hipOccupancyMaxActiveBlocksPerMultiprocessor(&per_cu, (const void*)fwd_megakernel, NTHREADS, LDS_BYTES);
        if (per_cu < 1) { fprintf(stderr, "kernel_launch: occupancy query says %d blocks per CU\n", per_cu); per_cu = 1; }
        (void)hipGetLastError();
        grid = cus;
    }
    if (grid < 0) return;
    Params p{};
    for (int i = 0; i < 21; ++i) p.in[i] = (const float*)d_in[i];
    p.out = (float*)d_out; p.ws = (unsigned char*)d_ws;
    if (hipMemsetAsync((char*)d_ws + WS_BAR, 0, BAR_BYTES, stream) != hipSuccess) { fprintf(stderr, "kernel_launch: memset of barrier words failed\n"); return; }
    void* args[] = {&p};
    hipError_t e = hipLaunchCooperativeKernel((const void*)fwd_megakernel, dim3(grid), dim3(NTHREADS), args, LDS_BYTES, stream);
    if (e != hipSuccess) fprintf(stderr, "cooperative launch failed: %s (grid %d)\n", hipGetErrorString(e), grid);
}
```

```cpp
#include <hip/hip_runtime.h>
#include <hip/hip_cooperative_groups.h>
#include <cstdio>
#include <cstdint>
namespace cg = cooperative_groups;
namespace pg8 {
#define PG8_LAS __attribute__((address_space(3)))
typedef unsigned short bf16_t;
typedef short bf16x8 __attribute__((ext_vector_type(8)));
typedef float f32x4 __attribute__((ext_vector_type(4)));
typedef unsigned u32x4 __attribute__((ext_vector_type(4)));
constexpr int BM = 256, BK = 64, HALF = 128, HTB = HALF * BK * 2  , STAGE_BYTES = 8 * HTB, NXCD = 8, WGM = 8;

__host__ __device__ __forceinline__ int lds_byte(int r, int c) { const int st = (r >> 4) * 2 + (c >> 5), rr = r & 15, cc = c & 31, ob = rr * 64 + cc * 2; return st * 1024 + (ob ^ (((ob >> 9) & 1) << 5)); }
__host__ __device__ __forceinline__ void stage_rc(int b, int& R, int& C) { const int st = b / 1024, sb = b % 1024, swz = sb ^ (((sb >> 9) & 1) << 5); R = (st >> 1) * 16 + swz / 64; C = (st & 1) * 32 + (swz % 64) / 2; }
__host__ __device__ __forceinline__ int perm32(int rho) { const int n = rho >> 4, i = rho & 15; return 8 * (i >> 2) + 4 * n + (i & 3); }

struct Unit { int pm, pn; };
struct Gemm { const bf16_t* A; const bf16_t* Bt; int M, N, K, lda; };

struct StaticOrder {
    int nM, nN, nwg, G, c;
    __host__ __device__ void init(int M, int N, int G_, int c_) { nM = M / BM; nN = N / BM; nwg = nM * nN; G = G_; c = c_; }
    __host__ __device__ bool next(int i, Unit& u) const {
        const long L = (long)i * G + c; if (L >= nwg) return false;
        int wgid = (int)L; { const int q = nwg / NXCD, r = nwg % NXCD, xcd = wgid % NXCD, off = wgid / NXCD; wgid = (xcd < r ? xcd * (q + 1) : r * (q + 1) + (xcd - r) * q) + off; }
        const int nig = WGM * nN, gid = wgid / nig, fm = gid * WGM, gsz = (nM - fm) < WGM ? (nM - fm) : WGM;
        u.pm = fm + ((wgid % nig) % gsz); u.pn = (wgid % nig) / gsz; return true;
    }
    __device__ __forceinline__ void a_ready(const Unit&) const {}
    __device__ __forceinline__ void done(const Unit&) const {}
};

__device__ __forceinline__ unsigned cvt_pk_bf16(float lo, float hi) { unsigned r; asm volatile("v_cvt_pk_bf16_f32 %0, %1, %2" : "=v"(r) : "v"(lo), "v"(hi)); return r; }
typedef float f32x2 __attribute__((ext_vector_type(2)));
__device__ __forceinline__ f32x2 gelu_pk(f32x2 v) {
    const f32x2 av = __builtin_elementwise_abs(v), d = av * 0.2316418882f + 1.0f;
    f32x2 t; t.x = __builtin_amdgcn_rcpf(d.x); t.y = __builtin_amdgcn_rcpf(d.y);
    f32x2 q = t * 0.5307027145f + (-0.7265760135f); q = q * t + 0.7107068705f; q = q * t + (-0.142248368f); q = q * t + 0.127414796f; q = q * t;
    const f32x2 s = (v * v) * (-0.72134752044f);
    f32x2 e; e.x = __builtin_amdgcn_exp2f(s.x); e.y = __builtin_amdgcn_exp2f(s.y);
    const f32x2 m = v * (q * e), r = v - m;
    f32x2 o; o.x = v.x < 0.f ? m.x : r.x; o.y = v.y < 0.f ? m.y : r.y; return o;
}

template <int ACT  > struct EpiBf16 {
    static constexpr bool PERM = true, AFTER_DRAIN = false; static_assert(ACT == 0 || ACT == 1, "EpiBf16: ACT is 0 (none) or 1 (gelu_pk)");
    bf16_t* O; int ldc; const float* bias; int split_cols; size_t split_stride; float scale0;
    __device__ __forceinline__ void operator()(const f32x4 (&acc)[2][2][4][2], const Unit& u, int wr, int wc, int fr, int fq) const {
        const int row0 = u.pm * BM + wr * 64 + fr; int colt = u.pn * BM; bf16_t* base = O;
        float sc = 1.f; if (split_cols) { const int t = colt / split_cols; base += (size_t)t * split_stride; colt -= t * split_cols; if (t == 0) sc = scale0; }
        const int col0 = colt + wc * 32 + 8 * fq, bcol0 = u.pn * BM + wc * 32 + 8 * fq;
        f32x4 bv[2][2];
#pragma unroll
        for (int bj = 0; bj < 2; ++bj)
#pragma unroll
            for (int n = 0; n < 2; ++n) bv[bj][n] = bias ? *(const f32x4*)(bias + bcol0 + bj * HALF + 4 * n) : (f32x4){0.f, 0.f, 0.f, 0.f};
#pragma unroll
        for (int ai = 0; ai < 2; ++ai)
#pragma unroll
            for (int m = 0; m < 4; ++m) { bf16_t* rowp = base + (size_t)(row0 + ai * HALF + m * 16) * ldc + col0;
#pragma unroll
                for (int bj = 0; bj < 2; ++bj) { f32x4 v0 = acc[ai][bj][m][0] + bv[bj][0], v1 = acc[ai][bj][m][1] + bv[bj][1];
                    if (ACT == 1) { f32x2 a = gelu_pk((f32x2){v0[0], v0[1]}), b = gelu_pk((f32x2){v0[2], v0[3]}), c = gelu_pk((f32x2){v1[0], v1[1]}), d = gelu_pk((f32x2){v1[2], v1[3]});
                        v0 = (f32x4){a.x, a.y, b.x, b.y}; v1 = (f32x4){c.x, c.y, d.x, d.y}; }
                    v0 = v0 * sc; v1 = v1 * sc; u32x4 w; w.x = cvt_pk_bf16(v0[0], v0[1]); w.y = cvt_pk_bf16(v0[2], v0[3]); w.z = cvt_pk_bf16(v1[0], v1[1]); w.w = cvt_pk_bf16(v1[2], v1[3]);
                    *(u32x4*)(rowp + bj * HALF) = w; } }
    }
};
template <class Epi, class Sched, bool ALIGN_EPI = false, bool SP2 = false>
__device__ __forceinline__ void gemm_phase(PG8_LAS unsigned char* lds, const Gemm g, const Sched& S, const Epi& E) {
    const int tid = threadIdx.x, wid = __builtin_amdgcn_readfirstlane(tid >> 6), lane = tid & 63, wr = wid >> 2, wc = wid & 3, fr = lane & 15, fq = lane >> 4;
    const int K = g.K, nt = K / BK;
    unsigned voffA[2], voffB[2];
#pragma unroll
    for (int i = 0; i < 2; ++i) { int R, C; stage_rc(tid * 16 + i * 8192, R, C); const int Rb = Epi::PERM ? ((R & ~31) + perm32(R & 31)) : R;
        voffA[i] = (unsigned)(R * g.lda + C) * 2u; voffB[i] = (unsigned)(Rb * K + C) * 2u; }
    const size_t kstep = (size_t)(BK * 2);
    const size_t hstepA = (size_t)HALF * g.lda * 2, hstepB = (size_t)HALF * K * 2;
    const size_t tstepA = 2 * hstepA, tstepB = 2 * hstepB;
    const unsigned ldsw = (unsigned)wid * 1024u;
    const int aoff = lds_byte(wr * 64 + fr, fq * 8), boff = lds_byte(wc * 32 + fr, fq * 8);
#define PG8_SA(b, h) (((b) * 2 + (h)) * HTB)
#define PG8_SB(b, h) ((4 + (b) * 2 + (h)) * HTB)
#define PG8_STAGE(bufoff, gbase, voff) do { _Pragma("unroll") for (int _i = 0; _i < 2; ++_i) \
        __builtin_amdgcn_global_load_lds((const unsigned*)((const char*)(gbase) + (voff)[_i]), (PG8_LAS unsigned*)(lds + (bufoff) + ldsw + _i * 8192), 16, 0, 0); } while (0)
#define PG8_LDA(dst, b, h) do { _Pragma("unroll") for (int m = 0; m < 4; ++m) _Pragma("unroll") for (int k = 0; k < 2; ++k) dst[m][k] = *(const PG8_LAS bf16x8*)(lds + PG8_SA(b, h) + aoff + m * 2048 + k * 1024); } while (0)
#define PG8_LDB(dst, b, h) do { _Pragma("unroll") for (int n = 0; n < 2; ++n) _Pragma("unroll") for (int k = 0; k < 2; ++k) dst[n][k] = *(const PG8_LAS bf16x8*)(lds + PG8_SB(b, h) + boff + n * 2048 + k * 1024); } while (0)
#define PG8_MMA(ai, bj, At, Bt) do { __builtin_amdgcn_s_setprio(1); _Pragma("unroll") for (int m = 0; m < 4; ++m) _Pragma("unroll") for (int n = 0; n < 2; ++n) _Pragma("unroll") for (int k = 0; k < 2; ++k) \
        acc[ai][bj][m][n] = __builtin_amdgcn_mfma_f32_16x16x32_bf16(Bt[n][k], At[m][k], acc[ai][bj][m][n], 0, 0, 0); __builtin_amdgcn_s_setprio(0); } while (0)
#define PG8_WAIT_V(n) asm volatile("s_waitcnt vmcnt(" #n ")" ::: "memory")
#define PG8_WAIT_L(n) asm volatile("s_waitcnt lgkmcnt(" #n ")" ::: "memory")
#define PG8_BAR __builtin_amdgcn_s_barrier()
#define PG8_SCHED __builtin_amdgcn_sched_barrier(0)
    Unit cur, nxt; int ui = 0;
    if (!S.next(0, cur)) return;
    f32x4 acc[2][2][4][2];
#pragma unroll
    for (int a = 0; a < 2; ++a)
#pragma unroll
        for (int b = 0; b < 2; ++b)
#pragma unroll
            for (int m = 0; m < 4; ++m)
#pragma unroll
                for (int n = 0; n < 2; ++n) acc[a][b][m][n] = (f32x4){0.f, 0.f, 0.f, 0.f};
    bf16x8 At[4][2], B0[2][2], B1[2][2];
    const char* cA = (const char*)g.A + (size_t)cur.pm * tstepA; const char* cB = (const char*)g.Bt + (size_t)cur.pn * tstepB;
    S.a_ready(cur);
    if constexpr (SP2) {
        PG8_STAGE(PG8_SB(0, 0), cB, voffB); PG8_STAGE(PG8_SB(0, 1), cB + hstepB, voffB); PG8_STAGE(PG8_SA(0, 0), cA, voffA); PG8_STAGE(PG8_SA(0, 1), cA + hstepA, voffA);
        if (wr == 1) PG8_BAR;
        PG8_WAIT_V(2); PG8_BAR;
        PG8_STAGE(PG8_SB(1, 0), cB + kstep, voffB); PG8_STAGE(PG8_SA(1, 0), cA + kstep, voffA); PG8_STAGE(PG8_SB(1, 1), cB + hstepB + kstep, voffB);
        PG8_WAIT_V(6); PG8_BAR;
    } else {
        PG8_STAGE(PG8_SB(0, 0), cB, voffB); PG8_STAGE(PG8_SA(0, 0), cA, voffA); PG8_STAGE(PG8_SB(0, 1), cB + hstepB, voffB); PG8_STAGE(PG8_SA(0, 1), cA + hstepA, voffA);
        if (wr == 1) PG8_BAR;
        PG8_WAIT_V(4); PG8_BAR;
        PG8_STAGE(PG8_SB(1, 0), cB + kstep, voffB); PG8_STAGE(PG8_SA(1, 0), cA + kstep, voffA); PG8_STAGE(PG8_SB(1, 1), cB + hstepB + kstep, voffB);
        PG8_WAIT_V(6); PG8_BAR;
    }
    for (;;) {
        const bool has_next = S.next(ui + 1, nxt);
        const char* nA = has_next ? (const char*)g.A + (size_t)nxt.pm * tstepA : cA; const char* nB = has_next ? (const char*)g.Bt + (size_t)nxt.pn * tstepB : cB;
        for (int t = 0; t < nt; t += 2) {
            const bool last = (t == nt - 2);
            const char* a1 = cA + (size_t)(t + 1) * kstep;
            const char* a2 = last ? nA : cA + (size_t)(t + 2) * kstep; const char* b2 = last ? nB : cB + (size_t)(t + 2) * kstep;
            const char* a3 = a2 + kstep; const char* b3 = b2 + kstep;
            if (last && has_next) S.a_ready(nxt);
            if constexpr (SP2) {
            PG8_LDB(B0, 0, 0); PG8_LDB(B1, 0, 1); PG8_SCHED; PG8_LDA(At, 0, 0); PG8_STAGE(PG8_SA(1, 1), a1 + hstepA, voffA);
            PG8_WAIT_V(8); PG8_WAIT_L(0); PG8_BAR; PG8_MMA(0, 0, At, B0); PG8_MMA(0, 1, At, B1); PG8_BAR; PG8_SCHED;
            PG8_LDA(At, 0, 1); PG8_STAGE(PG8_SB(0, 0), b2, voffB); PG8_STAGE(PG8_SB(0, 1), b2 + hstepB, voffB); PG8_STAGE(PG8_SA(0, 0), a2, voffA);
            PG8_WAIT_V(8); PG8_WAIT_L(0); PG8_BAR; PG8_MMA(1, 0, At, B0); PG8_MMA(1, 1, At, B1); PG8_BAR; PG8_SCHED;
            PG8_LDB(B0, 1, 0); PG8_LDB(B1, 1, 1); PG8_SCHED; PG8_LDA(At, 1, 0); PG8_STAGE(PG8_SA(0, 1), a2 + hstepA, voffA);
            PG8_WAIT_V(8); PG8_WAIT_L(0); PG8_BAR; PG8_MMA(0, 0, At, B0); PG8_MMA(0, 1, At, B1); PG8_BAR; PG8_SCHED;
            PG8_LDA(At, 1, 1); PG8_STAGE(PG8_SB(1, 0), b3, voffB); PG8_STAGE(PG8_SB(1, 1), b3 + hstepB, voffB); PG8_STAGE(PG8_SA(1, 0), a3, voffA);
            PG8_WAIT_V(8); PG8_WAIT_L(0); PG8_BAR; PG8_MMA(1, 0, At, B0); PG8_MMA(1, 1, At, B1); PG8_BAR; PG8_SCHED;
            } else {
            PG8_LDB(B0, 0, 0); PG8_SCHED; PG8_LDA(At, 0, 0); PG8_STAGE(PG8_SA(1, 1), a1 + hstepA, voffA);
            PG8_WAIT_L(8); PG8_BAR; PG8_WAIT_L(0); PG8_MMA(0, 0, At, B0); PG8_BAR; PG8_SCHED;
            PG8_LDB(B1, 0, 1); PG8_STAGE(PG8_SB(0, 0), b2, voffB);
            PG8_BAR; PG8_WAIT_L(0); PG8_MMA(0, 1, At, B1); PG8_BAR;
            PG8_LDA(At, 0, 1); PG8_STAGE(PG8_SA(0, 0), a2, voffA);
            PG8_BAR; PG8_WAIT_L(0); PG8_MMA(1, 0, At, B0); PG8_BAR; PG8_SCHED;
            PG8_STAGE(PG8_SB(0, 1), b2 + hstepB, voffB);
            PG8_WAIT_V(6); PG8_BAR; PG8_MMA(1, 1, At, B1); PG8_BAR;
            PG8_LDB(B0, 1, 0); PG8_SCHED; PG8_LDA(At, 1, 0); PG8_STAGE(PG8_SA(0, 1), a2 + hstepA, voffA);
            PG8_WAIT_L(8); PG8_BAR; PG8_WAIT_L(0); PG8_MMA(0, 0, At, B0); PG8_BAR; PG8_SCHED;
            PG8_LDB(B1, 1, 1); PG8_STAGE(PG8_SB(1, 0), b3, voffB);
            PG8_BAR; PG8_WAIT_L(0); PG8_MMA(0, 1, At, B1); PG8_BAR;
            PG8_LDA(At, 1, 1); PG8_STAGE(PG8_SA(1, 0), a3, voffA);
            PG8_BAR; PG8_WAIT_L(0); PG8_MMA(1, 0, At, B0); PG8_BAR; PG8_SCHED;
            PG8_STAGE(PG8_SB(1, 1), b3 + hstepB, voffB);
            PG8_WAIT_V(6); PG8_BAR; PG8_MMA(1, 1, At, B1); PG8_BAR;
            }
        }
        if constexpr (ALIGN_EPI) { if (wr == 0) PG8_BAR; }
        if constexpr (!Epi::AFTER_DRAIN) { E(acc, cur, wr, wc, fr, fq); S.done(cur); }
        if (!has_next) break;
#pragma unroll
        for (int a = 0; a < 2; ++a)
#pragma unroll
            for (int b = 0; b < 2; ++b)
#pragma unroll
                for (int m = 0; m < 4; ++m)
#pragma unroll
                    for (int n = 0; n < 2; ++n) acc[a][b][m][n] = (f32x4){0.f, 0.f, 0.f, 0.f};
        cur = nxt; cA = nA; cB = nB; ++ui;
        if constexpr (ALIGN_EPI) { if (wr == 1) PG8_BAR; }
    }
    PG8_WAIT_V(0);
    if constexpr (!ALIGN_EPI) { if (wr == 0) PG8_BAR; }
    PG8_BAR;
    if constexpr (Epi::AFTER_DRAIN) { E.fused(acc, cur, wr, wc, fr, fq, lds, wid, lane); S.done(cur); }
#undef PG8_SA
#undef PG8_SB
#undef PG8_STAGE
#undef PG8_LDA
#undef PG8_LDB
#undef PG8_MMA
#undef PG8_WAIT_V
#undef PG8_WAIT_L
#undef PG8_BAR
#undef PG8_SCHED
}
}

namespace pg8 {
typedef unsigned u32x2v __attribute__((ext_vector_type(2)));
__device__ __forceinline__ unsigned pk_bf16(float lo, float hi) { typedef float f2 __attribute__((ext_vector_type(2))); typedef __bf16 b2 __attribute__((ext_vector_type(2))); f2 v = {lo, hi}; b2 b = __builtin_convertvector(v, b2); return __builtin_bit_cast(unsigned, b); }
__device__ __forceinline__ float bf_lo(unsigned w) { return __uint_as_float(w << 16); }
__device__ __forceinline__ float bf_hi(unsigned w) { return __uint_as_float(w & 0xffff0000u); }
__device__ __forceinline__ u32x4 pk8(f32x4 a, f32x4 b) { u32x4 w; w.x = pk_bf16(a[0], a[1]); w.y = pk_bf16(a[2], a[3]); w.z = pk_bf16(b[0], b[1]); w.w = pk_bf16(b[2], b[3]); return w; }

struct EpiInProj {
    static constexpr bool PERM = true, AFTER_DRAIN = false;
    bf16_t* U; float* AUX; float qscale;
    __device__ __forceinline__ void operator()(const f32x4 (&acc)[2][2][4][2], const Unit& u, int wr, int wc, int fr, int fq) const {
        const int row0 = u.pm * BM + wr * 64 + fr;
        if (u.pn < 22) {
            const float sc = (u.pn < 4) ? qscale : 1.f;
            const int col0 = u.pn * BM + wc * 32 + 8 * fq;
#pragma unroll
            for (int ai = 0; ai < 2; ++ai)
#pragma unroll
                for (int m = 0; m < 4; ++m) { bf16_t* rowp = U + (size_t)(row0 + ai * HALF + m * 16) * 5632 + col0;
#pragma unroll
                    for (int bj = 0; bj < 2; ++bj) *(u32x4*)(rowp + bj * HALF) = pk8(acc[ai][bj][m][0] * sc, acc[ai][bj][m][1] * sc); }
        } else if (wc == 0) {
#pragma unroll
            for (int ai = 0; ai < 2; ++ai)
#pragma unroll
                for (int m = 0; m < 4; ++m) { float* rp = AUX + (size_t)(row0 + ai * HALF + m * 16) * 32 + 8 * fq;
                    *(f32x4*)rp = acc[ai][0][m][0]; *(f32x4*)(rp + 4) = acc[ai][0][m][1]; }
        }
    }
};
struct EpiPlainBf16 {
    static constexpr bool PERM = true, AFTER_DRAIN = false;
    bf16_t* O; int ldc;
    __device__ __forceinline__ void operator()(const f32x4 (&acc)[2][2][4][2], const Unit& u, int wr, int wc, int fr, int fq) const {
        const int row0 = u.pm * BM + wr * 64 + fr; const int col0 = u.pn * BM + wc * 32 + 8 * fq;
#pragma unroll
        for (int ai = 0; ai < 2; ++ai)
#pragma unroll
            for (int m = 0; m < 4; ++m) { bf16_t* rowp = O + (size_t)(row0 + ai * HALF + m * 16) * ldc + col0;
#pragma unroll
                for (int bj = 0; bj < 2; ++bj) *(u32x4*)(rowp + bj * HALF) = pk8(acc[ai][bj][m][0], acc[ai][bj][m][1]); }
    }
};
struct EpiRowScaleBf16 {
    static constexpr bool PERM = true, AFTER_DRAIN = false;
    bf16_t* O; int ldc; const float* rowsq;
    __device__ __forceinline__ void operator()(const f32x4 (&acc)[2][2][4][2], const Unit& u, int wr, int wc, int fr, int fq) const {
        const int row0 = u.pm * BM + wr * 64 + fr; const int col0 = u.pn * BM + wc * 32 + 8 * fq;
#pragma unroll
        for (int ai = 0; ai < 2; ++ai)
#pragma unroll
            for (int m = 0; m < 4; ++m) { const int row = row0 + ai * HALF + m * 16; const float rs = 1.0f / sqrtf(rowsq[row] * (1.0f / 2048.0f) + 1e-6f);
                bf16_t* rowp = O + (size_t)row * ldc + col0;
#pragma unroll
                for (int bj = 0; bj < 2; ++bj) *(u32x4*)(rowp + bj * HALF) = pk8(acc[ai][bj][m][0] * rs, acc[ai][bj][m][1] * rs); }
    }
};
__device__ __forceinline__ float dpp_ror1(float v) { return __int_as_float(__builtin_amdgcn_update_dpp(0, __float_as_int(v), 0x121, 0xf, 0xf, false)); }
__device__ __forceinline__ float dpp_ror2(float v) { return __int_as_float(__builtin_amdgcn_update_dpp(0, __float_as_int(v), 0x122, 0xf, 0xf, false)); }
struct EpiGateUp {
    static constexpr bool PERM = true, AFTER_DRAIN = false;
    bf16_t* ACT; const float* rowsq; const float* cw; const float* cb; float* GH; PG8_LAS float* halo;
    __device__ __forceinline__ void operator()(const f32x4 (&acc)[2][2][4][2], const Unit& u, int wr, int wc, int fr, int fq) const {
        const int row0 = u.pm * BM + wr * 64 + fr; const int lc = wc * 32 + 8 * fq, ch0 = u.pn * 128 + lc;
        float rs[2][4];
#pragma unroll
        for (int ai = 0; ai < 2; ++ai)
#pragma unroll
            for (int m = 0; m < 4; ++m) rs[ai][m] = 1.0f / sqrtf(rowsq[row0 + ai * HALF + m * 16] * (1.0f / 2048.0f) + 1e-6f);
        if (fr >= 14) {
#pragma unroll
            for (int ai = 0; ai < 2; ++ai) { PG8_LAS float* hp = halo + ((2 * ai + wr) * 2 + (fr - 14)) * 128 + lc;
                *(PG8_LAS f32x4*)hp = acc[ai][0][3][0] * rs[ai][3]; *(PG8_LAS f32x4*)(hp + 4) = acc[ai][0][3][1] * rs[ai][3]; }
            if (wr == 1) { float* gp = GH + ((size_t)u.pm * 6 + (fr - 14)) * 5632 + ch0; *(f32x4*)gp = acc[1][0][3][0] * rs[1][3]; *(f32x4*)(gp + 4) = acc[1][0][3][1] * rs[1][3]; }
        }
        if (fr < 2 && wr == 0) { float* gp = GH + ((size_t)u.pm * 6 + 2 + fr) * 5632 + ch0; *(f32x4*)gp = acc[0][0][0][0] * rs[0][0]; *(f32x4*)(gp + 4) = acc[0][0][0][1] * rs[0][0];
            float* up_ = GH + ((size_t)u.pm * 6 + 4 + fr) * 5632 + ch0; *(f32x4*)up_ = acc[0][1][0][0] * rs[0][0]; *(f32x4*)(up_ + 4) = acc[0][1][0][1] * rs[0][0]; }
        asm volatile("s_waitcnt lgkmcnt(0)" ::: "memory"); __builtin_amdgcn_s_barrier(); asm volatile("" ::: "memory");
#pragma unroll
        for (int n = 0; n < 2; ++n) {
            const f32x4 w0 = *(const f32x4*)(cw + ch0 + 4 * n), w1 = *(const f32x4*)(cw + 5632 + ch0 + 4 * n), w2 = *(const f32x4*)(cw + 2 * 5632 + ch0 + 4 * n), bb = *(const f32x4*)(cb + ch0 + 4 * n);
#pragma unroll
            for (int ai = 0; ai < 2; ++ai) {
                const int b = 2 * ai + wr;
                f32x4 c1 = {0.f, 0.f, 0.f, 0.f}, c2 = {0.f, 0.f, 0.f, 0.f};
                if (b >= 1) { const f32x4 p1 = *(PG8_LAS const f32x4*)(halo + ((b - 1) * 2 + 1) * 128 + lc + 4 * n), p2 = *(PG8_LAS const f32x4*)(halo + ((b - 1) * 2 + 0) * 128 + lc + 4 * n);
                    c1 = p1; c2 = (fr == 0) ? p2 : p1; }
#pragma unroll
                for (int m = 0; m < 4; ++m) {
                    const f32x4 g = acc[ai][0][m][n] * rs[ai][m], up = acc[ai][1][m][n] * rs[ai][m];
                    f32x4 a;
#pragma unroll
                    for (int i = 0; i < 4; ++i) { const float r1 = dpp_ror1(g[i]), r2 = dpp_ror2(g[i]);
                        const float gm1 = (fr == 0) ? c1[i] : r1, gm2 = (fr < 2) ? c2[i] : r2; c1[i] = r1; c2[i] = r2;
                        const float v = bb[i] + w0[i] * gm2 + w1[i] * gm1 + w2[i] * g[i]; a[i] = v / (1.0f + __expf(-v)) * up[i]; }
                    u32x2v o; o.x = pk_bf16(a[0], a[1]); o.y = pk_bf16(a[2], a[3]);
                    *(u32x2v*)(ACT + (size_t)(row0 + ai * HALF + m * 16) * 5632 + ch0 + 4 * n) = o;
                }
            }
        }
    }
};
template <int MODE> struct EpiRes {
    static constexpr bool PERM = true, AFTER_DRAIN = false;
    const float* base; float* out; bf16_t* XW; const float* nw; float* rowsq_out; const float* rowsq_in; const bf16_t* PP;
    __device__ __forceinline__ void operator()(const f32x4 (&acc)[2][2][4][2], const Unit& u, int wr, int wc, int fr, int fq) const {
        const int row0 = u.pm * BM + wr * 64 + fr; const int col0 = u.pn * BM + wc * 32 + 8 * fq;
        f32x4 nwv[2][2];
#pragma unroll
        for (int bj = 0; bj < 2; ++bj)
#pragma unroll
            for (int n = 0; n < 2; ++n) nwv[bj][n] = (MODE != 2) ? *(const f32x4*)(nw + col0 + bj * HALF + 4 * n) : (f32x4){0.f, 0.f, 0.f, 0.f};
#pragma unroll
        for (int ai = 0; ai < 2; ++ai)
#pragma unroll
            for (int m = 0; m < 4; ++m) {
                const int row = row0 + ai * HALF + m * 16; const size_t off = (size_t)row * 2048 + col0;
                float rs = 0.f; if (MODE == 2) rs = 1.0f / sqrtf(rowsq_in[row] * (1.0f / 2048.0f) + 1e-6f);
                float ss = 0.f;
#pragma unroll
                for (int bj = 0; bj < 2; ++bj) {
                    const f32x4 b0 = *(const f32x4*)(base + off + bj * HALF), b1 = *(const f32x4*)(base + off + bj * HALF + 4);
                    f32x4 a0 = acc[ai][bj][m][0], a1 = acc[ai][bj][m][1];
                    if (MODE == 2) {
                        const u32x4 pw = *(const u32x4*)(PP + off + bj * HALF);
                        const f32x4 p0 = {bf_lo(pw.x), bf_hi(pw.x), bf_lo(pw.y), bf_hi(pw.y)}, p1 = {bf_lo(pw.z), bf_hi(pw.z), bf_lo(pw.w), bf_hi(pw.w)};
#pragma unroll
                        for (int i = 0; i < 4; ++i) { a0[i] = p0[i] / (1.0f + __expf(-rs * a0[i])); a1[i] = p1[i] / (1.0f + __expf(-rs * a1[i])); }
                    }
                    const f32x4 x0 = b0 + a0, x1 = b1 + a1;
                    *(f32x4*)(out + off + bj * HALF) = x0; *(f32x4*)(out + off + bj * HALF + 4) = x1;
                    ss += (x0[0] * x0[0] + x0[1] * x0[1]) + (x0[2] * x0[2] + x0[3] * x0[3]) + (x1[0] * x1[0] + x1[1] * x1[1]) + (x1[2] * x1[2] + x1[3] * x1[3]);
                    if (MODE != 2) *(u32x4*)(XW + off + bj * HALF) = pk8(x0 * nwv[bj][0], x1 * nwv[bj][1]);
                }
                ss += __shfl_xor(ss, 16); ss += __shfl_xor(ss, 32);
                if (fq == 0) unsafeAtomicAdd(rowsq_out + row, ss);
            }
    }
};
}

using pg8::bf16_t; using pg8::bf16x8; using pg8::f32x4; using pg8::u32x4; using pg8::pk_bf16; using pg8::pk8; using pg8::bf_lo; using pg8::bf_hi;
typedef float f32x16 __attribute__((ext_vector_type(16)));
typedef unsigned u32x2 __attribute__((ext_vector_type(2)));
typedef short s16x4 __attribute__((ext_vector_type(4)));
constexpr int SEQ = 8192, DM = 2048, UP = 5632, NIN = 5888, DFF = 5632, GUP = 11264;
constexpr float LOG2E = 1.4426950408889634f;
constexpr float QSCALE = 0.125f * LOG2E;
constexpr size_t MiB = 1u << 20;
constexpr size_t WS_RS1 = 0, WS_RS2 = 32768, WS_RS3 = 65536, WS_RSS = 98304, WS_CD = 131072, WS_CL = 262144, WS_AUX = 1 * MiB;
constexpr size_t WS_BAR = 2 * MiB, BAR_BYTES = 16384;
constexpr size_t WS_WGU = 4 * MiB, WS_WD = 48 * MiB, WS_WPG = 70 * MiB, WS_WPP = 78 * MiB, WS_XW = 79 * MiB, WS_PP = 111 * MiB;
constexpr size_t WS_WIN = 143 * MiB, WS_WOUT = 166 * MiB, WS_P16 = 174 * MiB, WS_U = 178 * MiB, WS_VT = 266 * MiB, WS_ST = 282 * MiB, WS_YC = 314 * MiB, WS_GU = 143 * MiB;
constexpr size_t WS_GH = 240 * MiB;
constexpr size_t WS_END = 346 * MiB;
constexpr int LDS_BYTES = 147456;
constexpr int NTHREADS = 512;

__device__ __forceinline__ float bf2f(bf16_t b) { return __uint_as_float((unsigned)b << 16); }
__device__ __forceinline__ bf16_t f2bf(float f) { return (bf16_t)(pk_bf16(f, 0.f) & 0xffffu); }
__device__ __forceinline__ float s2f(short s) { return __uint_as_float(((unsigned)(unsigned short)s) << 16); }
__device__ __forceinline__ float wave_sum(float v) {
#pragma unroll
    for (int o = 1; o < 64; o <<= 1) v += __shfl_xor(v, o);
    return v;
}
#define LDS_WAIT() asm volatile("s_waitcnt lgkmcnt(0)" ::: "memory")
#define LAS __attribute__((address_space(3)))

__device__ __forceinline__ int inproj_src(int np) { if (np < 3072) return np; if (np < 5632) return np + 16; if (np < 5648) return 3072 + (np - 5632); if (np < 5664) return np; return -1; }

template <int MAP> __device__ __forceinline__ void transpose_item(const float* __restrict__ W, int K, int N, int ND, bf16_t* WT, float* scr, int item, int lane) {
    const int nblk = ND / 64, kb = item / nblk, nb = item % nblk, k0 = 64 * kb, n0 = 64 * nb;
    const int c4 = (lane & 15) * 4, r4 = lane >> 4;
    int src = n0 + c4; if (MAP == 1) src = inproj_src(src); if (MAP == 2) src = ((n0 >> 7) & 1) * 5632 + (n0 >> 8) * 128 + (n0 & 127) + c4;
    f32x4 v[16];
#pragma unroll
    for (int i = 0; i < 16; ++i) v[i] = (src >= 0) ? *(const f32x4*)(W + (size_t)(k0 + 4 * i + r4) * N + src) : (f32x4){0.f, 0.f, 0.f, 0.f};
#pragma unroll
    for (int i = 0; i < 16; ++i) { float* d = scr + (4 * i + r4) * 65 + c4; d[0] = v[i][0]; d[1] = v[i][1]; d[2] = v[i][2]; d[3] = v[i][3]; }
    LDS_WAIT();
    const int c = lane & 7;
#pragma unroll
    for (int j = 0; j < 8; ++j) { const int n = (lane >> 3) + 8 * j; const float* s = scr + (8 * c) * 65 + n;
        u32x4 o; o.x = pk_bf16(s[0 * 65], s[1 * 65]); o.y = pk_bf16(s[2 * 65], s[3 * 65]); o.z = pk_bf16(s[4 * 65], s[5 * 65]); o.w = pk_bf16(s[6 * 65], s[7 * 65]);
        *(u32x4*)(WT + (size_t)(n0 + n) * K + k0 + 8 * c) = o; }
    LDS_WAIT();
}
__device__ __forceinline__ void rms_row_to_bf16(const float* __restrict__ xrow, const float* __restrict__ w, bf16_t* orow, int lane) {
    const f32x4* xr = (const f32x4*)xrow + lane; const f32x4* wr = (const f32x4*)w + lane;
    f32x4 v[8]; float s = 0.f;
#pragma unroll
    for (int j = 0; j < 8; ++j) { v[j] = xr[64 * j]; s += (v[j].x * v[j].x + v[j].y * v[j].y) + (v[j].z * v[j].z + v[j].w * v[j].w); }
    const float rstd = 1.0f / sqrtf(wave_sum(s) * (1.0f / 2048.0f) + 1e-6f);
    u32x2* o8 = (u32x2*)orow + lane;
#pragma unroll
    for (int j = 0; j < 8; ++j) { const f32x4 wv = wr[64 * j]; u32x2 o; o.x = pk_bf16(v[j].x * rstd * wv.x, v[j].y * rstd * wv.y); o.y = pk_bf16(v[j].z * rstd * wv.z, v[j].w * rstd * wv.w); o8[64 * j] = o; }
}
__device__ __forceinline__ void conv4_silu8(const bf16_t* __restrict__ U, int t, int ch, const float* __restrict__ cw, const float* __restrict__ cb, f32x4& o0, f32x4& o1) {
    f32x4 a0 = *(const f32x4*)(cb + ch), a1 = *(const f32x4*)(cb + ch + 4);
#pragma unroll
    for (int k = 0; k < 4; ++k) { const int tt = t - 3 + k;
        if (tt >= 0) { const u32x4 v = *(const u32x4*)(U + (size_t)tt * UP + 3072 + ch); const f32x4 w0 = *(const f32x4*)(cw + k * 1536 + ch), w1 = *(const f32x4*)(cw + k * 1536 + ch + 4);
            a0[0] += w0[0] * bf_lo(v.x); a0[1] += w0[1] * bf_hi(v.x); a0[2] += w0[2] * bf_lo(v.y); a0[3] += w0[3] * bf_hi(v.y);
            a1[0] += w1[0] * bf_lo(v.z); a1[1] += w1[1] * bf_hi(v.z); a1[2] += w1[2] * bf_lo(v.w); a1[3] += w1[3] * bf_hi(v.w); } }
#pragma unroll
    for (int i = 0; i < 4; ++i) { a0[i] = a0[i] / (1.0f + __expf(-a0[i])); a1[i] = a1[i] / (1.0f + __expf(-a1[i])); }
    o0 = a0; o1 = a1;
}
typedef float f32x2v __attribute__((ext_vector_type(2)));
__device__ __forceinline__ float max3f(float a, float b, float c) { float r; asm("v_max3_f32 %0, %1, %2, %3" : "=v"(r) : "v"(a), "v"(b), "v"(c)); return r; }
__device__ __forceinline__ int crow(int r, int hi) { return (r & 3) + 8 * (r >> 2) + 4 * hi; }

constexpr int AT_K = 0, AT_V = 36864, AT_C = 71680;
__device__ __forceinline__ void fox_unit(unsigned char* lds, const bf16_t* __restrict__ U, const bf16_t* __restrict__ Vt, const float* __restrict__ CL, bf16_t* YC, int h, int qb) {
    const int tid = threadIdx.x, lane = tid & 63, r32 = lane & 31, hi = lane >> 5; const int wid = __builtin_amdgcn_readfirstlane(tid >> 6);
    const int q0 = qb * 256, qrow = q0 + wid * 32 + r32, qfirst = q0 + wid * 32;
    bf16x8 qr[4];
#pragma unroll
    for (int d0 = 0; d0 < 4; ++d0) qr[d0] = *(const bf16x8*)(U + (size_t)qrow * UP + h * 64 + d0 * 16 + hi * 8);
    const float cq = CL[h * SEQ + qrow];
    const int NT2 = 2 * (qb + 1);
    const int lrow = tid >> 3, lck = tid & 7;
    const bf16_t* ksrc = U + (size_t)lrow * UP + 1024 + h * 64 + lck * 8;
    const bf16_t* vsrc = Vt + (size_t)(h * 64 + lrow) * SEQ + lck * 8;
    const float* csrc = CL + h * SEQ + (tid & 31) * 4;
    const int kdoff = (lrow * 72 + lck * 8) * 2, vdoff = (lrow * 136 + lck * 8) * 2;
    u32x4 kreg0, kreg1, vreg0, vreg1; f32x4 creg = {0.f, 0.f, 0.f, 0.f};
    kreg0 = *(const u32x4*)ksrc; kreg1 = *(const u32x4*)(ksrc + (size_t)64 * UP); vreg0 = *(const u32x4*)vsrc; vreg1 = *(const u32x4*)(vsrc + 64); if (tid < 32) creg = *(const f32x4*)csrc;
    *(u32x4*)(lds + AT_K + kdoff) = kreg0; *(u32x4*)(lds + AT_K + kdoff + 64 * 144) = kreg1; *(u32x4*)(lds + AT_V + vdoff) = vreg0; *(u32x4*)(lds + AT_V + vdoff + 128) = vreg1;
    if (tid < 32) *(f32x4*)(lds + AT_C + tid * 16) = creg;
    __syncthreads();
    float mref = 0.f, lrun = 0.f; bool started = false;
    f32x16 o0 = {}, o1 = {};
    for (int T = 0; T < NT2; ++T) {
        const int cur = T & 1;
        if (T + 1 < NT2) { kreg0 = *(const u32x4*)(ksrc + (size_t)(T + 1) * 128 * UP); kreg1 = *(const u32x4*)(ksrc + (size_t)((T + 1) * 128 + 64) * UP);
            vreg0 = *(const u32x4*)(vsrc + (T + 1) * 128); vreg1 = *(const u32x4*)(vsrc + (T + 1) * 128 + 64); if (tid < 32) creg = *(const f32x4*)(csrc + (T + 1) * 128); }
#pragma unroll
        for (int sub = 0; sub < 2; ++sub) {
        const int t = 2 * T + sub;
        if (64 * t <= qfirst + 31) {
            const unsigned char* Kb = lds + AT_K + cur * 18432 + sub * 64 * 144; const unsigned char* Vb = lds + AT_V + cur * 17408 + sub * 128; const float* Cb = (const float*)(lds + AT_C + cur * 512 + sub * 256);
            f32x16 p0, p1;
            const f32x2v cqm = {cq - mref, cq - mref};
#pragma unroll
            for (int g = 0; g < 4; ++g) { const f32x4 c0 = *(const f32x4*)(Cb + 8 * g + 4 * hi), c1 = *(const f32x4*)(Cb + 32 + 8 * g + 4 * hi);
                const f32x2v a0 = cqm - (f32x2v){c0[0], c0[1]}, a1 = cqm - (f32x2v){c0[2], c0[3]}, b0 = cqm - (f32x2v){c1[0], c1[1]}, b1 = cqm - (f32x2v){c1[2], c1[3]};
                p0[4 * g] = a0.x; p0[4 * g + 1] = a0.y; p0[4 * g + 2] = a1.x; p0[4 * g + 3] = a1.y; p1[4 * g] = b0.x; p1[4 * g + 1] = b0.y; p1[4 * g + 2] = b1.x; p1[4 * g + 3] = b1.y; }
#pragma unroll
            for (int d0 = 0; d0 < 4; ++d0) {
                const bf16x8 a0 = *(const bf16x8*)(Kb + (r32 * 72 + d0 * 16 + hi * 8) * 2);
                const bf16x8 a1 = *(const bf16x8*)(Kb + ((32 + r32) * 72 + d0 * 16 + hi * 8) * 2);
                p0 = __builtin_amdgcn_mfma_f32_32x32x16_bf16(a0, qr[d0], p0, 0, 0, 0);
                p1 = __builtin_amdgcn_mfma_f32_32x32x16_bf16(a1, qr[d0], p1, 0, 0, 0);
            }
            if (64 * t + 63 > qfirst) {
#pragma unroll
                for (int r = 0; r < 16; ++r) { const int kv = 64 * t + crow(r, hi); if (kv > qrow) p0[r] = -INFINITY; if (kv + 32 > qrow) p1[r] = -INFINITY; }
            }
            float ra = max3f(p0[0], p0[1], p1[0]), rb = max3f(p0[2], p0[3], p1[1]); ra = max3f(ra, p1[2], p1[3]);
#pragma unroll
            for (int r = 4; r < 16; r += 4) { ra = max3f(ra, p0[r], p0[r + 1]); rb = max3f(rb, p0[r + 2], p0[r + 3]); ra = max3f(ra, p1[r], p1[r + 1]); rb = max3f(rb, p1[r + 2], p1[r + 3]); }
            float rm = fmaxf(ra, rb);
            { auto rr = __builtin_amdgcn_permlane32_swap(__float_as_uint(rm), __float_as_uint(rm), false, false); rm = fmaxf(__uint_as_float(rr[0]), __uint_as_float(rr[1])); }
            if (!started || __any(rm > 8.0f)) {
                const float dl = started ? fmaxf(rm, 0.f) : rm; mref += dl;
                const float alpha = started ? __builtin_amdgcn_exp2f(-dl) : 0.f;
#pragma unroll
                for (int r = 0; r < 16; ++r) { p0[r] -= dl; p1[r] -= dl; }
                lrun *= alpha;
#pragma unroll
                for (int r = 0; r < 16; ++r) { o0[r] *= alpha; o1[r] *= alpha; }
                started = true;
            }
            f32x2v ls2 = {0.f, 0.f};
#pragma unroll
            for (int r = 0; r < 16; r += 2) { p0[r] = __builtin_amdgcn_exp2f(p0[r]); p0[r + 1] = __builtin_amdgcn_exp2f(p0[r + 1]); p1[r] = __builtin_amdgcn_exp2f(p1[r]); p1[r + 1] = __builtin_amdgcn_exp2f(p1[r + 1]);
                ls2 += (f32x2v){p0[r], p0[r + 1]}; ls2 += (f32x2v){p1[r], p1[r + 1]}; }
            lrun += ls2.x + ls2.y;
#pragma unroll
            for (int b = 0; b < 2; ++b)
#pragma unroll
                for (int s = 0; s < 2; ++s) {
                    u32x4 pw;
                    if (b == 0) { pw.x = pk_bf16(p0[8 * s + 0], p0[8 * s + 1]); pw.y = pk_bf16(p0[8 * s + 2], p0[8 * s + 3]); pw.z = pk_bf16(p0[8 * s + 4], p0[8 * s + 5]); pw.w = pk_bf16(p0[8 * s + 6], p0[8 * s + 7]); }
                    else        { pw.x = pk_bf16(p1[8 * s + 0], p1[8 * s + 1]); pw.y = pk_bf16(p1[8 * s + 2], p1[8 * s + 3]); pw.z = pk_bf16(p1[8 * s + 4], p1[8 * s + 5]); pw.w = pk_bf16(p1[8 * s + 6], p1[8 * s + 7]); }
                    const bf16x8 pb = __builtin_bit_cast(bf16x8, pw);
                    const int kvo = 32 * b + 16 * s + 4 * hi;
                    {   const u32x2 v0 = *(const u32x2*)(Vb + (r32 * 136 + kvo) * 2), v1 = *(const u32x2*)(Vb + (r32 * 136 + kvo + 8) * 2);
                        const u32x4 vv = {v0.x, v0.y, v1.x, v1.y}; o0 = __builtin_amdgcn_mfma_f32_32x32x16_bf16(__builtin_bit_cast(bf16x8, vv), pb, o0, 0, 0, 0); }
                    {   const u32x2 v0 = *(const u32x2*)(Vb + ((32 + r32) * 136 + kvo) * 2), v1 = *(const u32x2*)(Vb + ((32 + r32) * 136 + kvo + 8) * 2);
                        const u32x4 vv = {v0.x, v0.y, v1.x, v1.y}; o1 = __builtin_amdgcn_mfma_f32_32x32x16_bf16(__builtin_bit_cast(bf16x8, vv), pb, o1, 0, 0, 0); }
                }
        }
        }
        if (T + 1 < NT2) { const int nb = (cur ^ 1); *(u32x4*)(lds + AT_K + nb * 18432 + kdoff) = kreg0; *(u32x4*)(lds + AT_K + nb * 18432 + kdoff + 64 * 144) = kreg1;
            *(u32x4*)(lds + AT_V + nb * 17408 + vdoff) = vreg0; *(u32x4*)(lds + AT_V + nb * 17408 + vdoff + 128) = vreg1; if (tid < 32) *(f32x4*)(lds + AT_C + nb * 512 + tid * 16) = creg; }
        __syncthreads();
    }
    { auto rr = __builtin_amdgcn_permlane32_swap(__float_as_uint(lrun), __float_as_uint(lrun), false, false); lrun = __uint_as_float(rr[0]) + __uint_as_float(rr[1]); }
    const float inv = 1.0f / lrun;
    bf16_t* orow = YC + (size_t)qrow * 2048 + h * 64 + 4 * hi;
#pragma unroll
    for (int g = 0; g < 4; ++g) {
        u32x2 w0, w1;
        w0.x = pk_bf16(o0[4 * g] * inv, o0[4 * g + 1] * inv); w0.y = pk_bf16(o0[4 * g + 2] * inv, o0[4 * g + 3] * inv);
        w1.x = pk_bf16(o1[4 * g] * inv, o1[4 * g + 1] * inv); w1.y = pk_bf16(o1[4 * g + 2] * inv, o1[4 * g + 3] * inv);
        *(u32x2*)(orow + 8 * g) = w0; *(u32x2*)(orow + 32 + 8 * g) = w1;
    }
}
#define XB_TMO      128
#define XB_XCNT(j)  (256  + 64 * (j))
#define XB_XSUB(j)  (1280 + 64 * (j))
#define XB_XGEN(j)  (2304 + 64 * (j))
#define XB_TOP      3328
#define XB_TOPGEN   3392
#define XCD_BAR_WORDS 3456
#define XB_SPIN_CAP (1u << 18)

__device__ __forceinline__ unsigned xb_ld(unsigned* p)              { return __hip_atomic_load(p, __ATOMIC_RELAXED, __HIP_MEMORY_SCOPE_AGENT); }
__device__ __forceinline__ unsigned xb_add(unsigned* p, unsigned v) { return __hip_atomic_fetch_add(p, v, __ATOMIC_RELAXED, __HIP_MEMORY_SCOPE_AGENT); }
__device__ __forceinline__ unsigned xb_xcc_id() { return (unsigned)__builtin_amdgcn_s_getreg((3 << 11) | 20) & 0xFu; }
#define XB_SPIN(cond, bar) do { unsigned _sp = 0; while (cond) { __builtin_amdgcn_s_sleep(1); \
    if ((++_sp & 255u) == 0u) { if (xb_ld(&(bar)[XB_TMO])) break; if (_sp > XB_SPIN_CAP) { atomicAdd(&(bar)[XB_TMO], 1u); break; } } } } while (0)

struct XcdBarrier {
    unsigned* bar; unsigned x;
    volatile LAS unsigned* st;
};

__device__ __forceinline__ XcdBarrier xcd_barrier_post(unsigned* bar, volatile LAS unsigned* st) {
    XcdBarrier b; b.bar = bar; b.x = xb_xcc_id(); b.st = st;
    if (threadIdx.x == 0) (void)xb_add(&bar[XB_XCNT(b.x)], 1u);
    return b;
}
__device__ __forceinline__ void xcd_barrier_complete(unsigned* bar, unsigned x, unsigned& nloc, unsigned& nx) {
    const unsigned G = gridDim.x * gridDim.y * gridDim.z;
    unsigned sum, cnt, mine, sp = 0u;
    for (;;) {
        sum = 0u; cnt = 0u; mine = 0u;
#pragma unroll
        for (unsigned j = 0; j < 16; ++j) { const unsigned c = xb_ld(&bar[XB_XCNT(j)]); sum += c; cnt += (c > 0u) ? 1u : 0u; mine = (j == x) ? c : mine; }
        if (sum == G) break;
        __builtin_amdgcn_s_sleep(1);
        if ((++sp & 255u) == 0u) { if (xb_ld(&bar[XB_TMO])) break; if (sp > XB_SPIN_CAP) { atomicAdd(&bar[XB_TMO], 1u); break; } }
    }
    nloc = mine > 0u ? mine : 1u; nx = cnt > 0u ? cnt : 1u;
}

__device__ __forceinline__ void xcd_barrier(const XcdBarrier& b) {
    asm volatile("s_waitcnt vmcnt(0)" ::: "memory");
    __syncthreads();
    if (threadIdx.x == 0) {
        unsigned* bar = b.bar;
        __builtin_amdgcn_s_waitcnt(0);
        unsigned nloc = b.st[0], nx = b.st[1];
        if (nloc == 0u) { xcd_barrier_complete(bar, b.x, nloc, nx); b.st[0] = nloc; b.st[1] = nx; }
        const unsigned old = xb_add(&bar[XB_XSUB(b.x)], 1u);
        const unsigned gen = old / nloc;
        if (old + 1u == (gen + 1u) * nloc) {
            __builtin_amdgcn_fence(__ATOMIC_RELEASE, "agent");
            asm volatile("s_waitcnt vmcnt(0)" ::: "memory");
            const unsigned og = xb_add(&bar[XB_TOP], 1u);
            const unsigned tg = og / nx;
            if (og + 1u == (tg + 1u) * nx) xb_add(&bar[XB_TOPGEN], 1u);
            else XB_SPIN(xb_ld(&bar[XB_TOPGEN]) == tg, bar);
            __builtin_amdgcn_fence(__ATOMIC_ACQUIRE, "agent");
            xb_add(&bar[XB_XGEN(b.x)], 1u);
            asm volatile("s_waitcnt vmcnt(0)" ::: "memory");
        } else {
            XB_SPIN(xb_ld(&bar[XB_XGEN(b.x)]) == gen, bar);
            __builtin_amdgcn_fence(__ATOMIC_ACQUIRE, "agent");
            asm volatile("s_waitcnt vmcnt(0)" ::: "memory");
        }
    }
    __syncthreads();
}

constexpr int SL_XT = 0;
constexpr int SL_CM = 73728;
constexpr int SL_BM = 91136;
constexpr int SL_GG = 108544;
constexpr int SL_DT = 125952, SL_AC = 128000, SL_SW = 130048;

#ifndef PHMASK
#define PHMASK 0xFFFF
#endif
#define PH(n) ((PHMASK >> (n)) & 1)
struct Params { const float* in[21]; float* out; unsigned char* ws; };

__device__ __forceinline__ void ssd_stage_xt_dt(unsigned char* lds, const bf16_t* U, const float* AUX, const float* cw, const float* cb, float dtb, float Ah, int t0, int h, int wave, int lane, float& dt_out, float& ac_out) {
    bf16_t* XT = (bf16_t*)(lds + SL_XT + wave * 9216);
#pragma unroll 2
    for (int it = 0; it < 8; ++it) { const int idx = it * 64 + lane, s = idx >> 3, ck = idx & 7; f32x4 a0, a1; conv4_silu8(U, t0 + s, h * 64 + ck * 8, cw, cb, a0, a1);
#pragma unroll
        for (int i = 0; i < 4; ++i) { XT[(ck * 8 + i) * 72 + s] = f2bf(a0[i]); XT[(ck * 8 + 4 + i) * 72 + s] = f2bf(a1[i]); } }
    const float xr = AUX[(size_t)(t0 + lane) * 32 + 16 + h] + dtb;
    const float dt = (xr > 20.f) ? xr : log1pf(expf(xr));
    float ac = dt * Ah;
#pragma unroll
    for (int o = 1; o < 64; o <<= 1) { const float n = __shfl_up(ac, o); if (lane >= o) ac += n; }
    dt_out = dt; ac_out = ac;
}

__global__ void __launch_bounds__(NTHREADS, 2) fwd_megakernel(Params P) {
    extern __shared__ __attribute__((aligned(16))) unsigned char lds[];
    cg::grid_group grid = cg::this_grid();
    const int G = gridDim.x, bid = blockIdx.x, nthr = G * NTHREADS;
#define TVARS int tid = threadIdx.x; asm volatile("" : "+v"(tid)); const int lane = tid & 63, wave = __builtin_amdgcn_readfirstlane(tid >> 6), quad = lane >> 4, l15 = lane & 15, gtid = bid * NTHREADS + tid; (void)quad; (void)l15; (void)gtid; (void)wave; (void)lane;
    unsigned char* ws = P.ws;
    const float* x = P.in[0]; float* out = P.out;
    float* RS1 = (float*)(ws + WS_RS1); float* RS2 = (float*)(ws + WS_RS2); float* RS3 = (float*)(ws + WS_RS3); float* RSS = (float*)(ws + WS_RSS);
    float* CD = (float*)(ws + WS_CD); float* CL = (float*)(ws + WS_CL); float* AUX = (float*)(ws + WS_AUX);
    bf16_t* Wgu_t = (bf16_t*)(ws + WS_WGU); bf16_t* Wd_t = (bf16_t*)(ws + WS_WD); bf16_t* Wpg_t = (bf16_t*)(ws + WS_WPG); bf16_t* Wpp_t = (bf16_t*)(ws + WS_WPP);
    bf16_t* XW = (bf16_t*)(ws + WS_XW); bf16_t* PP = (bf16_t*)(ws + WS_PP); bf16_t* Win_t = (bf16_t*)(ws + WS_WIN); bf16_t* Wout_t = (bf16_t*)(ws + WS_WOUT);
    bf16_t* P16 = (bf16_t*)(ws + WS_P16); bf16_t* U = (bf16_t*)(ws + WS_U); bf16_t* Vt = (bf16_t*)(ws + WS_VT); bf16_t* ST = (bf16_t*)(ws + WS_ST);
    bf16_t* YC = (bf16_t*)(ws + WS_YC); bf16_t* GU = (bf16_t*)(ws + WS_GU);
    __attribute__((address_space(3))) unsigned char* glds = (__attribute__((address_space(3))) unsigned char*)lds;
    if (threadIdx.x < 16) ((volatile LAS unsigned*)(glds + LDS_BYTES - 64))[threadIdx.x] = 0u;
    __syncthreads();
    const XcdBarrier xbar = xcd_barrier_post((unsigned*)(ws + WS_BAR), (volatile LAS unsigned*)(glds + LDS_BYTES - 64));
#define GRID_BAR() xcd_barrier(xbar)

#ifndef REP_P0
#define REP_P0 1
#endif
#ifndef REP_P2
#define REP_P2 1
#endif
#ifndef EXTRA_SYNCS
#define EXTRA_SYNCS 0
#endif
    for (int rep0 = 0; rep0 < REP_P0; ++rep0) if (PH(0)) { TVARS
        float* scr = (float*)(lds + wave * 16640);
        const int gw = bid * 8 + wave, NGW = G * 8;
        constexpr int I_IN = 32 * 92, I_OUT = 32 * 32, I_GU = 32 * 176, I_D = 88 * 32, I_PG = 32 * 32, I_PP = 4 * 32;
        constexpr int NITEMS = I_IN + I_OUT + I_GU + I_D + I_PG + I_PP;
        for (int it = gw; it < NITEMS; it += NGW) {
            int r = it;
            if (r < I_IN) { transpose_item<1>(P.in[3], 2048, 5664, NIN, Win_t, scr, r, lane); continue; } r -= I_IN;
            if (r < I_OUT) { transpose_item<0>(P.in[11], 2048, 2048, 2048, Wout_t, scr, r, lane); continue; } r -= I_OUT;
            if (r < I_GU) { transpose_item<2>(P.in[13], 2048, GUP, GUP, Wgu_t, scr, r, lane); continue; } r -= I_GU;
            if (r < I_D) { transpose_item<0>(P.in[16], DFF, 2048, 2048, Wd_t, scr, r, lane); continue; } r -= I_D;
            if (r < I_PG) { transpose_item<0>(P.in[18], 2048, 2048, 2048, Wpg_t, scr, r, lane); continue; } r -= I_PG;
            transpose_item<0>(P.in[19], 256, 2048, 2048, Wpp_t, scr, r, lane);
        }
        for (int m = gw; m < SEQ; m += NGW) rms_row_to_bf16(x + (size_t)m * DM, P.in[2], XW + (size_t)m * DM, lane);
        const float* pin = P.in[1];
        for (int i = gtid; i < SEQ * 256 / 8; i += nthr) { const f32x4 a = *(const f32x4*)(pin + (size_t)i * 8), b = *(const f32x4*)(pin + (size_t)i * 8 + 4); *(u32x4*)(P16 + (size_t)i * 8) = pk8(a, b); }
        for (int i = gtid; i < 4 * SEQ; i += nthr) RS1[i] = 0.f;
    }
    if (P.ws == nullptr) grid.sync();
    GRID_BAR();

    if (PH(1)) {
        pg8::Gemm g{XW, Win_t, SEQ, NIN, DM, DM}; pg8::StaticOrder S; S.init(SEQ, NIN, G, bid);
        pg8::EpiInProj E{U, AUX, QSCALE};
        pg8::gemm_phase<pg8::EpiInProj, pg8::StaticOrder, true, true>(glds, g, S, E);
    }
    if (PH(13)) {
        int kpp = 256; asm volatile("" : "+s"(kpp));
        pg8::Gemm g{P16, Wpp_t, SEQ, DM, kpp, kpp}; pg8::StaticOrder S; S.init(SEQ, DM, G, bid);
        pg8::EpiPlainBf16 E{PP, DM};
        pg8::gemm_phase<pg8::EpiPlainBf16, pg8::StaticOrder, true, true>(glds, g, S, E);
    }
    GRID_BAR();

#ifndef DUP_P1
#define DUP_P1 0
#endif
#ifndef DUP_P9
#define DUP_P9 0
#endif
#ifndef DUP_P10
#define DUP_P10 0
#endif
#if DUP_P1
    {
        pg8::Gemm g{XW, Win_t, SEQ, NIN, DM, DM}; pg8::StaticOrder S; S.init(SEQ, NIN, G, bid);
        pg8::EpiInProj E{U, AUX, QSCALE};
        pg8::gemm_phase<pg8::EpiInProj, pg8::StaticOrder, true, true>(glds, g, S, E);
    }
    GRID_BAR();
#endif
    for (int i = 0; i < EXTRA_SYNCS; ++i) GRID_BAR();
    for (int rep2 = 0; rep2 < REP_P2; ++rep2) {
    if (PH(2)) for (int h = bid; h < 16; h += G) { TVARS
        float* wsum = (float*)(lds + 140000);
        const float bfh = P.in[4][h]; const int t0 = tid * 16;
        float run = 0.f; float loc[16];
#pragma unroll
        for (int i = 0; i < 16; ++i) { const float xv = AUX[(size_t)(t0 + i) * 32 + h] + bfh; const float ls = fminf(xv, 0.f) - log1pf(expf(-fabsf(xv))); run += ls; loc[i] = run; }
        float incl = run;
#pragma unroll
        for (int o = 1; o < 64; o <<= 1) { const float n = __shfl_up(incl, o); if (lane >= o) incl += n; }
        if (lane == 63) wsum[wave] = incl;
        __syncthreads();
        float pre = 0.f;
#pragma unroll
        for (int w = 0; w < 8; ++w) { const float v = wsum[w]; if (w < wave) pre += v; }
        const float excl = pre + incl - run;
#pragma unroll
        for (int i = 0; i < 16; ++i) CL[h * SEQ + t0 + i] = (excl + loc[i]) * LOG2E;
        __syncthreads();
    }
    if (PH(2)) for (int it = bid; it < 2048; it += G) { TVARS
        const int h = it >> 7, tb = it & 127; bf16_t* tileT = (bf16_t*)(lds + 4096);
        const int row = tid >> 3, ck = tid & 7;
        const u32x4 v = *(const u32x4*)(U + (size_t)(tb * 64 + row) * UP + 2048 + h * 64 + ck * 8);
        tileT[(ck * 8 + 0) * 72 + row] = (bf16_t)(v.x & 0xffff); tileT[(ck * 8 + 1) * 72 + row] = (bf16_t)(v.x >> 16);
        tileT[(ck * 8 + 2) * 72 + row] = (bf16_t)(v.y & 0xffff); tileT[(ck * 8 + 3) * 72 + row] = (bf16_t)(v.y >> 16);
        tileT[(ck * 8 + 4) * 72 + row] = (bf16_t)(v.z & 0xffff); tileT[(ck * 8 + 5) * 72 + row] = (bf16_t)(v.z >> 16);
        tileT[(ck * 8 + 6) * 72 + row] = (bf16_t)(v.w & 0xffff); tileT[(ck * 8 + 7) * 72 + row] = (bf16_t)(v.w >> 16);
        __syncthreads();
        const u32x4 o = *(const u32x4*)(tileT + row * 72 + ck * 8);
        *(u32x4*)(Vt + (size_t)(h * 64 + row) * SEQ + tb * 64 + ck * 8) = o;
        __syncthreads();
    }
    if (PH(2)) { TVARS
        const float* cw = P.in[5]; const float* cb = P.in[6];
        for (int it = bid; it < 256; it += G) {
            const int c = it >> 1, g = it & 1, t0 = c * 64, h = g * 8 + wave;
            bf16_t* BMT = (bf16_t*)(lds + SL_CM);
            for (int idx = tid; idx < 1024; idx += NTHREADS) { const int s = idx >> 4, ck = idx & 15; f32x4 a0, a1; conv4_silu8(U, t0 + s, 1024 + g * 128 + ck * 8, cw, cb, a0, a1);
#pragma unroll
                for (int i = 0; i < 4; ++i) { BMT[(ck * 8 + i) * 72 + s] = f2bf(a0[i]); BMT[(ck * 8 + 4 + i) * 72 + s] = f2bf(a1[i]); } }
            float dt, ac; const float Ah = -expf(P.in[8][h]);
            ssd_stage_xt_dt(lds, U, AUX, cw, cb, P.in[7][h], Ah, t0, h, wave, lane, dt, ac);
            const float ac63 = __shfl(ac, 63);
            float* SW = (float*)(lds + SL_SW + wave * 256);
            SW[lane] = expf(ac63 - ac) * dt;
            if (lane == 0) CD[c * 16 + h] = expf(ac63);
            __syncthreads();
            const bf16_t* XT = (const bf16_t*)(lds + SL_XT + wave * 9216);
            for (int pt = 0; pt < 4; ++pt) {
                bf16x8 af[2];
#pragma unroll
                for (int ks = 0; ks < 2; ++ks) { const bf16x8 xa = *(const bf16x8*)(XT + (pt * 16 + l15) * 72 + ks * 32 + quad * 8);
                    const f32x4 w0 = *(const f32x4*)(SW + ks * 32 + quad * 8), w1 = *(const f32x4*)(SW + ks * 32 + quad * 8 + 4);
                    u32x4 pw; pw.x = pk_bf16(s2f(xa[0]) * w0[0], s2f(xa[1]) * w0[1]); pw.y = pk_bf16(s2f(xa[2]) * w0[2], s2f(xa[3]) * w0[3]);
                    pw.z = pk_bf16(s2f(xa[4]) * w1[0], s2f(xa[5]) * w1[1]); pw.w = pk_bf16(s2f(xa[6]) * w1[2], s2f(xa[7]) * w1[3]);
                    af[ks] = __builtin_bit_cast(bf16x8, pw); }
                f32x4 acc[8];
#pragma unroll
                for (int nt = 0; nt < 8; ++nt) { acc[nt] = (f32x4){0.f, 0.f, 0.f, 0.f};
#pragma unroll
                    for (int ks = 0; ks < 2; ++ks) { const bf16x8 b = *(const bf16x8*)(BMT + (nt * 16 + l15) * 72 + ks * 32 + quad * 8);
                        acc[nt] = __builtin_amdgcn_mfma_f32_16x16x32_bf16(af[ks], b, acc[nt], 0, 0, 0); } }
#pragma unroll
                for (int nt = 0; nt < 8; ++nt)
#pragma unroll
                    for (int r = 0; r < 4; ++r) ST[((size_t)(c * 16 + h) * 64 + pt * 16 + quad * 4 + r) * 128 + nt * 16 + l15] = f2bf(acc[nt][r]);
            }
            __syncthreads();
        }
    }
    }
    GRID_BAR();

#ifndef REP_P3
#define REP_P3 1
#endif
#ifndef REP_S3
#define REP_S3 1
#endif
    if (PH(3)) for (int rep3 = 0; rep3 < REP_P3; ++rep3) { TVARS bf16_t* STD = (rep3 + 1 < REP_P3) ? (bf16_t*)out : ST; for (int e = gtid; e < 131072; e += nthr) {
        const int h = e >> 13; float run = 0.f;
        for (int c0 = 0; c0 < 128; c0 += 8) {
            float sv[8], dv[8];
#pragma unroll
            for (int j = 0; j < 8; ++j) { sv[j] = bf2f(ST[(size_t)(c0 + j) * 131072 + e]); dv[j] = CD[(c0 + j) * 16 + h]; }
#pragma unroll
            for (int j = 0; j < 8; ++j) { STD[(size_t)(c0 + j) * 131072 + e] = f2bf(run); run = run * dv[j] + sv[j]; }
        }
    } }
    GRID_BAR();

    { TVARS
        const float* cw = P.in[5]; const float* cb = P.in[6]; const float* nw = P.in[10];
        for (int reps = 0; reps < REP_S3; ++reps) { bf16_t* YCD = (reps + 1 < REP_S3) ? (bf16_t*)out : YC; float* RSD = (reps + 1 < REP_S3) ? (out + 12 * 1024 * 1024) : RSS;
        if (PH(4)) for (int it = bid; it < 256; it += G) {
            const int c = it >> 1, g = it & 1, t0 = c * 64, h = g * 8 + wave;
            bf16_t* CM = (bf16_t*)(lds + SL_CM); bf16_t* BM = (bf16_t*)(lds + SL_BM); float* GG = (float*)(lds + SL_GG);
            for (int idx = tid; idx < 2048; idx += NTHREADS) { const int which = idx >> 10, s = (idx >> 4) & 63, ck = idx & 15; f32x4 a0, a1;
                conv4_silu8(U, t0 + s, 1024 + which * 256 + g * 128 + ck * 8, cw, cb, a0, a1);
                *(u32x4*)((which ? CM : BM) + s * 136 + ck * 8) = pk8(a0, a1); }
            float dt, ac; const float Ah = -expf(P.in[8][h]);
            ssd_stage_xt_dt(lds, U, AUX, cw, cb, P.in[7][h], Ah, t0, h, wave, lane, dt, ac);
            float* SDT = (float*)(lds + SL_DT + wave * 256); float* SAC = (float*)(lds + SL_AC + wave * 256);
            SDT[lane] = dt; SAC[lane] = ac;
            __syncthreads();
#pragma unroll
            for (int k2 = 0; k2 < 2; ++k2) { const int id = 2 * wave + k2, lt = id >> 2, st = id & 3; f32x4 acc = {0.f, 0.f, 0.f, 0.f};
#pragma unroll
                for (int ks = 0; ks < 4; ++ks) { const bf16x8 a = *(const bf16x8*)(CM + (lt * 16 + l15) * 136 + ks * 32 + quad * 8), b = *(const bf16x8*)(BM + (st * 16 + l15) * 136 + ks * 32 + quad * 8);
                    acc = __builtin_amdgcn_mfma_f32_16x16x32_bf16(a, b, acc, 0, 0, 0); }
#pragma unroll
                for (int r = 0; r < 4; ++r) GG[(lt * 16 + quad * 4 + r) * 68 + st * 16 + l15] = acc[r]; }
            __syncthreads();
            const bf16_t* XT = (const bf16_t*)(lds + SL_XT + wave * 9216);
            const float Dh = P.in[9][h];
            const bf16_t* HP = ST + (size_t)(c * 16 + h) * 64 * 128;
            for (int lt = 0; lt < 4; ++lt) {
                const int la = lt * 16 + l15; const float acl = SAC[la];
                f32x4 yd[4], yo[4];
#pragma unroll
                for (int pt = 0; pt < 4; ++pt) { yd[pt] = (f32x4){0.f, 0.f, 0.f, 0.f}; yo[pt] = (f32x4){0.f, 0.f, 0.f, 0.f}; }
#pragma unroll
                for (int ks = 0; ks < 2; ++ks) {
                    if (ks * 32 <= lt * 16 + 15) {
                        const int s0 = ks * 32 + quad * 8;
                        const f32x4 g0 = *(const f32x4*)(GG + la * 68 + s0), g1 = *(const f32x4*)(GG + la * 68 + s0 + 4);
                        const f32x4 e0 = *(const f32x4*)(SAC + s0), e1 = *(const f32x4*)(SAC + s0 + 4), d0 = *(const f32x4*)(SDT + s0), d1 = *(const f32x4*)(SDT + s0 + 4);
                        float mv[8];
#pragma unroll
                        for (int j = 0; j < 4; ++j) { mv[j] = (s0 + j <= la) ? g0[j] * __expf(fminf(acl - e0[j], 0.f)) * d0[j] : 0.f; mv[4 + j] = (s0 + 4 + j <= la) ? g1[j] * __expf(fminf(acl - e1[j], 0.f)) * d1[j] : 0.f; }
                        u32x4 pw; pw.x = pk_bf16(mv[0], mv[1]); pw.y = pk_bf16(mv[2], mv[3]); pw.z = pk_bf16(mv[4], mv[5]); pw.w = pk_bf16(mv[6], mv[7]);
                        const bf16x8 a = __builtin_bit_cast(bf16x8, pw);
#pragma unroll
                        for (int pt = 0; pt < 4; ++pt) { const bf16x8 b = *(const bf16x8*)(XT + (pt * 16 + l15) * 72 + s0); yd[pt] = __builtin_amdgcn_mfma_f32_16x16x32_bf16(a, b, yd[pt], 0, 0, 0); }
                    }
                }
#pragma unroll
                for (int ks = 0; ks < 4; ++ks) { const bf16x8 a = *(const bf16x8*)(CM + la * 136 + ks * 32 + quad * 8);
#pragma unroll
                    for (int pt = 0; pt < 4; ++pt) { const bf16x8 b = *(const bf16x8*)(HP + (size_t)(pt * 16 + l15) * 128 + ks * 32 + quad * 8); yo[pt] = __builtin_amdgcn_mfma_f32_16x16x32_bf16(a, b, yo[pt], 0, 0, 0); } }
                const int lc = lt * 16 + quad * 4;
                const f32x4 eav = *(const f32x4*)(SAC + lc);
                float ea[4], rsum[4];
#pragma unroll
                for (int r = 0; r < 4; ++r) { ea[r] = __expf(eav[r]); rsum[r] = 0.f; }
#pragma unroll
                for (int pt = 0; pt < 4; ++pt) { const int p = pt * 16 + l15; const u32x2 xw = *(const u32x2*)(XT + p * 72 + lc);
                    const float xv[4] = {bf_lo(xw.x), bf_hi(xw.x), bf_lo(xw.y), bf_hi(xw.y)}; const float nwp = nw[h * 64 + p];
#pragma unroll
                    for (int r = 0; r < 4; ++r) { const int t = t0 + lc + r; float y = yd[pt][r] + ea[r] * yo[pt][r] + Dh * xv[r];
                        const float z = bf2f(U[(size_t)t * UP + 4608 + h * 64 + p]); y *= z / (1.0f + __expf(-z)); rsum[r] += y * y;
                        YCD[(size_t)t * 2048 + 1024 + h * 64 + p] = f2bf(y * nwp); } }
#pragma unroll
                for (int r = 0; r < 4; ++r) { float v = rsum[r]; v += __shfl_xor(v, 1); v += __shfl_xor(v, 2); v += __shfl_xor(v, 4); v += __shfl_xor(v, 8); if (l15 == 0) unsafeAtomicAdd(RSD + t0 + lc + r, v); }
            }
            __syncthreads();
        }
        }
#ifndef REP_ATT
#define REP_ATT 1
#endif
        if (PH(12)) for (int rep = 0; rep < REP_ATT; ++rep) for (int it = bid; it < 256; it += G) { const int h = it >> 4, s = it & 15;
            fox_unit(lds, U, Vt, CL, YC, h, 31 - s);
            fox_unit(lds, U, Vt, CL, YC, h, s); }
    }
    GRID_BAR();

#ifndef REP_SMALL
#define REP_SMALL 1
#endif
    if (PH(5)) for (int rp = 0; rp < REP_SMALL; ++rp) { TVARS bf16_t* YD = (rp + 1 < REP_SMALL) ? (bf16_t*)out : YC; for (int i = gtid; i < SEQ * 128; i += nthr) { const int row = i >> 7, ck = i & 127; const float rs = 1.0f / sqrtf(RSS[row] * (1.0f / 1024.0f) + 1e-6f);
        bf16_t* p = YC + (size_t)row * 2048 + 1024 + ck * 8; const u32x4 v = *(const u32x4*)p;
        u32x4 o; o.x = pk_bf16(bf_lo(v.x) * rs, bf_hi(v.x) * rs); o.y = pk_bf16(bf_lo(v.y) * rs, bf_hi(v.y) * rs); o.z = pk_bf16(bf_lo(v.z) * rs, bf_hi(v.z) * rs); o.w = pk_bf16(bf_lo(v.w) * rs, bf_hi(v.w) * rs);
        *(u32x4*)(YD + (size_t)row * 2048 + 1024 + ck * 8) = o; } }
    GRID_BAR();

    if (PH(6)) {
        pg8::Gemm g{YC, Wout_t, SEQ, DM, DM, DM}; pg8::StaticOrder S; S.init(SEQ, DM, G, bid);
        pg8::EpiRes<0> E{x, out, XW, P.in[12], RS1, nullptr, nullptr};
        pg8::gemm_phase<pg8::EpiRes<0>, pg8::StaticOrder, true, true>(glds, g, S, E);
    }
    GRID_BAR();

#ifndef REP_GU
#define REP_GU 1
#endif
    if (PH(7)) {
        pg8::Gemm g{XW, Wgu_t, SEQ, GUP, DM, DM}; pg8::StaticOrder S; S.init(SEQ, GUP, G, bid);
        pg8::EpiGateUp E{GU, RS1, P.in[14], P.in[15], (float*)(ws + WS_GH), (PG8_LAS float*)(glds + 131072)};
        pg8::gemm_phase<pg8::EpiGateUp, pg8::StaticOrder, true, true>(glds, g, S, E);
    }
    GRID_BAR();

    if (PH(8)) { TVARS
        const float* fw = P.in[14]; const float* fb = P.in[15]; const float* GH = (const float*)(ws + WS_GH);
        for (int it = gtid; it < 31 * 2 * 704; it += nthr) {
            const int ck = it % 704, r = it / 704, j = r & 1, pm = 1 + (r >> 1), col = ck * 8;
            const float* gm2p = GH + ((size_t)(pm - 1) * 6 + j) * 5632 + col;
            const float* gm1p = j ? GH + ((size_t)pm * 6 + 2) * 5632 + col : GH + ((size_t)(pm - 1) * 6 + 1) * 5632 + col;
            const float* g0p = GH + ((size_t)pm * 6 + 2 + j) * 5632 + col; const float* upp = GH + ((size_t)pm * 6 + 4 + j) * 5632 + col;
            f32x4 o[2];
#pragma unroll
            for (int q = 0; q < 2; ++q) { const f32x4 a2 = *(const f32x4*)(gm2p + 4 * q), a1 = *(const f32x4*)(gm1p + 4 * q), a0 = *(const f32x4*)(g0p + 4 * q), uu = *(const f32x4*)(upp + 4 * q);
                const f32x4 w0 = *(const f32x4*)(fw + col + 4 * q), w1 = *(const f32x4*)(fw + DFF + col + 4 * q), w2 = *(const f32x4*)(fw + 2 * DFF + col + 4 * q), bb = *(const f32x4*)(fb + col + 4 * q);
#pragma unroll
                for (int i = 0; i < 4; ++i) { const float v = bb[i] + w0[i] * a2[i] + w1[i] * a1[i] + w2[i] * a0[i]; o[q][i] = v / (1.0f + __expf(-v)) * uu[i]; } }
            *(u32x4*)(GU + (size_t)(pm * 256 + j) * DFF + col) = pk8(o[0], o[1]);
        }
    }
    GRID_BAR();

#if DUP_P9
    {
        pg8::Gemm g{GU + DFF, Wd_t, SEQ, DM, DFF, GUP}; pg8::StaticOrder S; S.init(SEQ, DM, G, bid);
        pg8::EpiRes<1> E{out, (float*)Wgu_t, Win_t, P.in[17], (float*)(ws + 3 * MiB), nullptr, nullptr};
        pg8::gemm_phase<pg8::EpiRes<1>, pg8::StaticOrder, true, true>(glds, g, S, E);
    }
    GRID_BAR();
#endif
    if (PH(9)) {
        pg8::Gemm g{GU, Wd_t, SEQ, DM, DFF, DFF}; pg8::StaticOrder S; S.init(SEQ, DM, G, bid);
        pg8::EpiRes<1> E{out, out, XW, P.in[17], RS2, nullptr, nullptr};
        pg8::gemm_phase<pg8::EpiRes<1>, pg8::StaticOrder, true, true>(glds, g, S, E);
    }
    GRID_BAR();

#if DUP_P10
    {
        pg8::Gemm g{XW, Wpg_t, SEQ, DM, DM, DM}; pg8::StaticOrder S; S.init(SEQ, DM, G, bid);
        pg8::EpiRes<2> E{out, (float*)GU, nullptr, nullptr, (float*)(ws + 3 * MiB), RS2, PP};
        pg8::gemm_phase<pg8::EpiRes<2>, pg8::StaticOrder, true, true>(glds, g, S, E);
    }
    GRID_BAR();
#endif
    if (PH(10)) {
        pg8::Gemm g{XW, Wpg_t, SEQ, DM, DM, DM}; pg8::StaticOrder S; S.init(SEQ, DM, G, bid);
        pg8::EpiRes<2> E{out, out, nullptr, nullptr, RS3, RS2, PP};
        pg8::gemm_phase<pg8::EpiRes<2>, pg8::StaticOrder, true, true>(glds, g, S, E);
    }
    GRID_BAR();

    if (PH(11)) for (int rp = 0; rp < REP_SMALL; ++rp) { TVARS float* OD = (rp + 1 < REP_SMALL) ? (float*)GU : out;
        const float* fnw = P.in[20];
        for (int i = gtid; i < SEQ * 512; i += nthr) { const int row = i >> 9, c4 = i & 511; const float rs = 1.0f / sqrtf(RS3[row] * (1.0f / 2048.0f) + 1e-6f);
            const f32x4* p = (const f32x4*)(out + (size_t)row * DM) + c4; const f32x4 w = ((const f32x4*)fnw)[c4]; *((f32x4*)(OD + (size_t)row * DM) + c4) = (*p) * rs * w; }
    }
}

extern "C" void kernel_launch(void* const* d_in, const int* in_sizes, int n_in, void* d_out, int out_size, void* d_ws, size_t ws_size, hipStream_t stream) {
    static int grid = 0;
    if (grid == 0) {
        if (n_in != 21 || out_size != SEQ * DM || ws_size < WS_END) { fprintf(stderr, "kernel_launch: unexpected problem (n_in %d, out %d, ws %zu)\n", n_in, out_size, ws_size); grid = -1; return; }
        int dev = 0, cus = 0, per_cu = 0;
        hipGetDevice(&dev); hipDeviceGetAttribute(&cus, hipDeviceAttributeMultiprocessorCount, dev);
        hipFuncSetAttribute((const void*)fwd_megakernel, hipFuncAttributeMaxDynamicSharedMemorySize, LDS_BYTES);
        hipOccupancyMaxActiveBlocksPerMultiprocessor(&per_cu, (const void*)fwd_megakernel, NTHREADS, LDS_BYTES);
        if (per_cu < 1) { fprintf(stderr, "kernel_launch: occupancy query says %d blocks per CU\n", per_cu); per_cu = 1; }
        (void)hipGetLastError();
        grid = cus;
    }
    if (grid < 0) return;
    Params p{};
    for (int i = 0; i < 21; ++i) p.in[i] = (const float*)d_in[i];
    p.out = (float*)d_out; p.ws = (unsigned char*)d_ws;
    if (hipMemsetAsync((char*)d_ws + WS_BAR, 0, BAR_BYTES, stream) != hipSuccess) { fprintf(stderr, "kernel_launch: memset of barrier words failed\n"); return; }
    void* args[] = {&p};
    hipError_t e = hipLaunchCooperativeKernel((const void*)fwd_megakernel, dim3(grid), dim3(NTHREADS), args, LDS_BYTES, stream);
    if (e != hipSuccess) fprintf(stderr, "cooperative launch failed: %s (grid %d)\n", hipGetErrorString(e), grid);
}
```
